# Optimizing an MI355X kernel written in HIP

```python
import math
import jax, jax.numpy as jnp
from jax import lax
import numpy as np

D_MODEL = 2048
BATCH = 4
SEQ = 2048
DEPTH = 1
DEC_BATCH = 128
DEC_SEQ = 8
PAST_LEN = 16384
PAGE_SIZE = 128

D_RNN = D_MODEL // 2
RNN_BLOCKS = 8
RNN_BS = D_RNN // RNN_BLOCKS
RG_C = 8.0
CONV_W = 4
GDN_HEADS = 8
GDN_DK = 128
GDN_DV = 128
D_GDN_K = GDN_HEADS * GDN_DK
D_GDN_V = GDN_HEADS * GDN_DV
D_GDN_CONV = 2 * D_GDN_K + D_GDN_V
GDN_CHUNK = 64
MEM_LEN = 256
MEM_HEADS = 4
MEM_HD = D_MODEL // 8
D_MEM = MEM_HEADS * MEM_HD
N_BRANCH = 3
D_FF = 4 * D_MODEL
EPS = 1e-6
IN_SIZES = (D_RNN, D_RNN, D_GDN_K, D_GDN_K, D_GDN_V, D_GDN_V, GDN_HEADS, GDN_HEADS, D_MEM, N_BRANCH * D_MODEL)
N_IN = sum(IN_SIZES)
IN_SPLITS = tuple(sum(IN_SIZES[:i + 1]) for i in range(len(IN_SIZES) - 1))

kernel_name = 'hybrid_rglru_gdn_memxattn_decode_step'


def rmsnorm(x, g):
    xf = x.astype(jnp.float32)
    y = xf * lax.rsqrt(jnp.mean(xf * xf, axis=-1, keepdims=True) + EPS)
    return (y * g.astype(jnp.float32)).astype(x.dtype)


def l2norm(x):
    return x * lax.rsqrt(jnp.sum(x * x, axis=-1, keepdims=True) + EPS)


def causal_dwconv(x, buf, w):
    T = x.shape[1]
    xp = jnp.concatenate([buf.astype(x.dtype), x], axis=1)
    y = sum(xp[:, j:j + T] * w[j] for j in range(CONV_W))
    return y, xp[:, -(CONV_W - 1):]


def rglru(x, h0, wx, bx, wa, ba, L):
    B, T, _ = x.shape
    xb = x.reshape(B, T, RNN_BLOCKS, RNN_BS)
    gi = jax.nn.sigmoid(jnp.einsum('btni,nij->btnj', xb, wx).reshape(B, T, D_RNN) + bx).astype(jnp.float32)
    gr = jax.nn.sigmoid(jnp.einsum('btni,nij->btnj', xb, wa).reshape(B, T, D_RNN) + ba).astype(jnp.float32)
    log_a = RG_C * gr * jax.nn.log_sigmoid(L.astype(jnp.float32))
    a = jnp.exp(log_a)
    u = jnp.sqrt(-jnp.expm1(2.0 * log_a)) * (gi * x.astype(jnp.float32))
    u = u.at[:, 0].add(a[:, 0] * h0.astype(jnp.float32))

    def combine(left, right):
        a1, b1 = left
        a2, b2 = right
        return a1 * a2, a2 * b1 + b2

    _, h = lax.associative_scan(combine, (a, u), axis=1)
    return h, h[:, -1]


def gated_delta_chunked(q, k, v, g, beta, S0):
    B, T, H, _ = q.shape
    C = min(GDN_CHUNK, T)
    n = -(-T // C)
    pad = n * C - T

    def prep(t):
        t = jnp.pad(t.astype(jnp.float32), [(0, 0), (0, pad)] + [(0, 0)] * (t.ndim - 2))
        t = t.reshape((B, n, C) + t.shape[2:])
        return jnp.swapaxes(t, 2, 3)

    q, k, v, g, beta = prep(q), prep(k), prep(v), prep(g), prep(beta)
    gc = jnp.cumsum(g, axis=-1)
    incl = jnp.tril(jnp.ones((C, C), bool))
    strict = jnp.tril(jnp.ones((C, C), bool), -1)
    decay = jnp.exp(jnp.where(incl, gc[..., :, None] - gc[..., None, :], -jnp.inf))
    kb = k * beta[..., None]
    vb = v * beta[..., None]
    M = jnp.where(strict, jnp.einsum('bnhik,bnhjk->bnhij', kb, k) * decay, 0.0)
    eye = jnp.eye(C, dtype=jnp.float32)
    Tm = lax.linalg.triangular_solve(eye + M, jnp.broadcast_to(eye, M.shape), left_side=True, lower=True,
                                     unit_diagonal=True)
    value = jnp.einsum('bnhij,bnhjv->bnhiv', Tm, vb)
    kcd = jnp.einsum('bnhij,bnhjk->bnhik', Tm, kb * jnp.exp(gc)[..., None])

    def step(S, xs):
        q_c, k_c, val_c, kcd_c, gc_c, dec_c = xs
        v_new = val_c - jnp.einsum('bhck,bhkv->bhcv', kcd_c, S)
        attn = jnp.einsum('bhik,bhjk->bhij', q_c, k_c) * dec_c
        o = (jnp.einsum('bhck,bhkv->bhcv', q_c * jnp.exp(gc_c)[..., None], S)
             + jnp.einsum('bhij,bhjv->bhiv', attn, v_new))
        g_last = gc_c[..., -1]
        S = (S * jnp.exp(g_last)[..., None, None]
             + jnp.einsum('bhck,bhcv->bhkv', k_c * jnp.exp(g_last[..., None] - gc_c)[..., None], v_new))
        return S, o

    xs = tuple(jnp.moveaxis(t, 1, 0) for t in (q, k, value, kcd, gc, decay))
    S_final, o = lax.scan(step, S0.astype(jnp.float32), xs)
    o = jnp.transpose(o, (1, 0, 3, 2, 4)).reshape(B, n * C, H, GDN_DV)[:, :T]
    return o, S_final


def memory_kv(mem, g, w):
    B = mem.shape[0]
    kv = rmsnorm(mem, g) @ w
    k, v = jnp.split(kv, 2, axis=-1)
    return k.reshape(B, MEM_LEN, MEM_HEADS, MEM_HD), v.reshape(B, MEM_LEN, MEM_HEADS, MEM_HD)


def mix_branches(xn, mem_k, mem_v, rnn_buf, rnn_h0, gdn_buf, gdn_S0, w_in, rnn_conv_w, rnn_conv_b, rnn_wx,
                 rnn_bx, rnn_wa, rnn_ba, rnn_L, gdn_conv_w, gdn_A_log, gdn_dt_bias, gdn_norm_g, w_rnn_up,
                 w_gdn_up, w_mem_up, w_out):
    B, T, _ = xn.shape
    proj = xn @ w_in
    rx, rg, gq, gk, gv, gz, gb, ga, mq, mg = jnp.split(proj, IN_SPLITS, axis=-1)

    rx_c, rnn_buf_new = causal_dwconv(rx, rnn_buf, rnn_conv_w)
    h, h_last = rglru(rx_c + rnn_conv_b, rnn_h0, rnn_wx, rnn_bx, rnn_wa, rnn_ba, rnn_L)
    y_rnn = (h * jax.nn.gelu(rg.astype(jnp.float32))).astype(xn.dtype)

    qkv_c, gdn_buf_new = causal_dwconv(jnp.concatenate([gq, gk, gv], axis=-1), gdn_buf, gdn_conv_w)
    qkv_c = jax.nn.silu(qkv_c)
    q, k, v = jnp.split(qkv_c, (D_GDN_K, 2 * D_GDN_K), axis=-1)
    q = l2norm(q.reshape(B, T, GDN_HEADS, GDN_DK).astype(jnp.float32)) * (GDN_DK ** -0.5)
    k = l2norm(k.reshape(B, T, GDN_HEADS, GDN_DK).astype(jnp.float32))
    v = v.reshape(B, T, GDN_HEADS, GDN_DV)
    beta = jax.nn.sigmoid(gb.astype(jnp.float32))
    g = -jnp.exp(gdn_A_log.astype(jnp.float32)) * jax.nn.softplus(ga.astype(jnp.float32) + gdn_dt_bias.astype(jnp.float32))
    o, S_new = gated_delta_chunked(q, k, v, g, beta, gdn_S0)
    z = gz.reshape(B, T, GDN_HEADS, GDN_DV).astype(jnp.float32)
    o = rmsnorm(o, gdn_norm_g) * jax.nn.silu(z)
    y_gdn = o.reshape(B, T, D_GDN_V).astype(xn.dtype)

    qm = mq.reshape(B, T, MEM_HEADS, MEM_HD)
    s = jnp.einsum('bthd,bmhd->bhtm', qm, mem_k.astype(qm.dtype)).astype(jnp.float32) * (MEM_HD ** -0.5)
    p = jax.nn.softmax(s, axis=-1)
    om = jnp.einsum('bhtm,bmhd->bthd', p.astype(xn.dtype), mem_v.astype(xn.dtype)).reshape(B, T, D_MEM)

    gates = jax.nn.sigmoid(mg.reshape(B, T, N_BRANCH, D_MODEL))
    merged = (gates[:, :, 0] * (y_rnn @ w_rnn_up) + gates[:, :, 1] * (y_gdn @ w_gdn_up)
              + gates[:, :, 2] * (om @ w_mem_up))
    return merged @ w_out, (rnn_buf_new, h_last, gdn_buf_new, S_new)


def decoder_layer(x, mem_k, mem_v, rnn_buf, rnn_h0, gdn_buf, gdn_S0, norm_mix_g, mix_params, norm_mlp_g,
                  w_mlp_up, w_mlp_down):
    y_mix, states = mix_branches(rmsnorm(x, norm_mix_g), mem_k, mem_v, rnn_buf, rnn_h0, gdn_buf, gdn_S0,
                                 *mix_params)
    x = x + y_mix
    hid = rmsnorm(x, norm_mlp_g) @ w_mlp_up
    x = x + jnp.square(jax.nn.relu(hid)) @ w_mlp_down
    return x, states


def setup_inputs(seed: int = 0) -> dict:
    key = jax.random.key(seed)
    ks = iter(jax.random.split(key, 40))
    f32 = jnp.float32

    def nrm(shape, scale):
        return jax.random.normal(next(ks), shape, f32) * scale

    def gain(shape):
        return 1.0 + nrm(shape, 0.01)

    p_a = jax.random.uniform(next(ks), (DEPTH, D_RNN), f32, 0.9, 0.999) ** (1.0 / RG_C)
    dt = jax.random.uniform(next(ks), (DEPTH, GDN_HEADS), f32, 0.001, 0.1)
    return {
        'x_prompt': nrm((BATCH, SEQ, D_MODEL), 1.0),
        'x_sample': nrm((DEC_BATCH, DEC_SEQ, D_MODEL), 1.0),
        'mem_prompt': nrm((BATCH, MEM_LEN, D_MODEL), 1.0),
        'cache_mem_k': nrm((DEPTH, DEC_BATCH, MEM_LEN, MEM_HEADS, MEM_HD), 1.0),
        'cache_mem_v': nrm((DEPTH, DEC_BATCH, MEM_LEN, MEM_HEADS, MEM_HD), 1.0),
        'state_rnn_conv': nrm((DEPTH, DEC_BATCH, CONV_W - 1, D_RNN), 1.0),
        'state_rnn_h': nrm((DEPTH, DEC_BATCH, D_RNN), 0.5),
        'state_gdn_conv': nrm((DEPTH, DEC_BATCH, CONV_W - 1, D_GDN_CONV), 1.0),
        'state_gdn_S': nrm((DEPTH, DEC_BATCH, GDN_HEADS, GDN_DK, GDN_DV), 0.1),
        'norm_mix_g': gain((DEPTH, D_MODEL)),
        'w_in': nrm((DEPTH, D_MODEL, N_IN), D_MODEL ** -0.5),
        'rnn_conv_w': nrm((DEPTH, CONV_W, D_RNN), CONV_W ** -0.5),
        'rnn_conv_b': nrm((DEPTH, D_RNN), 0.01),
        'rnn_wx': nrm((DEPTH, RNN_BLOCKS, RNN_BS, RNN_BS), RNN_BS ** -0.5),
        'rnn_bx': nrm((DEPTH, D_RNN), 0.01),
        'rnn_wa': nrm((DEPTH, RNN_BLOCKS, RNN_BS, RNN_BS), RNN_BS ** -0.5),
        'rnn_ba': nrm((DEPTH, D_RNN), 0.01),
        'rnn_L': jnp.log(p_a) - jnp.log1p(-p_a),
        'gdn_conv_w': nrm((DEPTH, CONV_W, D_GDN_CONV), CONV_W ** -0.5),
        'gdn_A_log': jnp.log(jax.random.uniform(next(ks), (DEPTH, GDN_HEADS), f32, 1.0, 16.0)),
        'gdn_dt_bias': dt + jnp.log(-jnp.expm1(-dt)),
        'gdn_norm_g': gain((DEPTH, GDN_DV)),
        'mem_norm_g': gain((DEPTH, D_MODEL)),
        'w_mem_kv': nrm((DEPTH, D_MODEL, 2 * D_MEM), D_MODEL ** -0.5),
        'w_rnn_up': nrm((DEPTH, D_RNN, D_MODEL), D_RNN ** -0.5),
        'w_gdn_up': nrm((DEPTH, D_GDN_V, D_MODEL), D_GDN_V ** -0.5),
        'w_mem_up': nrm((DEPTH, D_MEM, D_MODEL), D_MEM ** -0.5),
        'w_out': nrm((DEPTH, D_MODEL, D_MODEL), D_MODEL ** -0.5),
        'norm_mlp_g': gain((DEPTH, D_MODEL)),
        'w_mlp_up': nrm((DEPTH, D_MODEL, D_FF), D_MODEL ** -0.5),
        'w_mlp_down': nrm((DEPTH, D_FF, D_MODEL), D_FF ** -0.5),
        'norm_final_g': gain((D_MODEL,)),
    }


def reference(x_prompt, x_sample, mem_prompt, cache_mem_k, cache_mem_v, state_rnn_conv, state_rnn_h,
              state_gdn_conv, state_gdn_S, norm_mix_g, w_in, rnn_conv_w, rnn_conv_b, rnn_wx, rnn_bx, rnn_wa,
              rnn_ba, rnn_L, gdn_conv_w, gdn_A_log, gdn_dt_bias, gdn_norm_g, mem_norm_g, w_mem_kv, w_rnn_up,
              w_gdn_up, w_mem_up, w_out, norm_mlp_g, w_mlp_up, w_mlp_down, norm_final_g):
    Bp = x_prompt.shape[0]
    hp, hs = x_prompt, x_sample
    mk_p, mv_p, rb_p, rh_p, gb_p, gs_p = [], [], [], [], [], []
    rb_s, rh_s, gb_s, gs_s = [], [], [], []
    for l in range(DEPTH):
        mix_params = (w_in[l], rnn_conv_w[l], rnn_conv_b[l], rnn_wx[l], rnn_bx[l], rnn_wa[l], rnn_ba[l],
                      rnn_L[l], gdn_conv_w[l], gdn_A_log[l], gdn_dt_bias[l], gdn_norm_g[l], w_rnn_up[l],
                      w_gdn_up[l], w_mem_up[l], w_out[l])
        mk, mv = memory_kv(mem_prompt, mem_norm_g[l], w_mem_kv[l])
        hp, (rb, rh, gb, gs) = decoder_layer(
            hp, mk, mv,
            jnp.zeros((Bp, CONV_W - 1, D_RNN), hp.dtype), jnp.zeros((Bp, D_RNN), jnp.float32),
            jnp.zeros((Bp, CONV_W - 1, D_GDN_CONV), hp.dtype),
            jnp.zeros((Bp, GDN_HEADS, GDN_DK, GDN_DV), jnp.float32),
            norm_mix_g[l], mix_params, norm_mlp_g[l], w_mlp_up[l], w_mlp_down[l])
        mk_p.append(mk); mv_p.append(mv); rb_p.append(rb); rh_p.append(rh); gb_p.append(gb); gs_p.append(gs)
        hs, (rb, rh, gb, gs) = decoder_layer(
            hs, cache_mem_k[l], cache_mem_v[l], state_rnn_conv[l], state_rnn_h[l], state_gdn_conv[l],
            state_gdn_S[l], norm_mix_g[l], mix_params, norm_mlp_g[l], w_mlp_up[l], w_mlp_down[l])
        rb_s.append(rb); rh_s.append(rh); gb_s.append(gb); gs_s.append(gs)
    y_prompt = rmsnorm(hp, norm_final_g)
    y_sample = rmsnorm(hs, norm_final_g)
    return (y_prompt, y_sample, jnp.stack(mk_p), jnp.stack(mv_p), jnp.stack(rb_p), jnp.stack(rh_p),
            jnp.stack(gb_p), jnp.stack(gs_p), jnp.stack(rb_s), jnp.stack(rh_s), jnp.stack(gb_s), jnp.stack(gs_s))
```

```cpp
#include <hip/hip_runtime.h>
#include <hip/hip_cooperative_groups.h>
#include <cstdio>
namespace cg = cooperative_groups;

#ifndef ONE_LAUNCH
#define ONE_LAUNCH 1
#endif
#ifndef DBG_DUMP
#define DBG_DUMP 0
#endif
#ifndef DBG_SEQ_SUM
#define DBG_SEQ_SUM 0
#endif
#ifndef DBG_PH_HI
#define DBG_PH_HI 9
#endif


#ifndef EN_ALL
#define EN_ALL 1
#endif
#ifndef EN_PREP
#define EN_PREP EN_ALL
#endif
#ifndef EN_ATTS
#define EN_ATTS EN_ALL
#endif
#ifndef EN_SEQ
#define EN_SEQ EN_ALL
#endif
#ifndef EN_RGP
#define EN_RGP EN_ALL
#endif
#ifndef EN_ATTP
#define EN_ATTP EN_ALL
#endif
#ifndef EN_GS
#define EN_GS EN_ALL
#endif
#ifndef EN_RGS
#define EN_RGS EN_ALL
#endif
#ifndef EN_GEMM
#define EN_GEMM EN_ALL
#endif
#define LAS __attribute__((address_space(3)))
typedef unsigned short bf16_t;
typedef short bf16x8 __attribute__((ext_vector_type(8)));
typedef short s16x4 __attribute__((ext_vector_type(4)));
typedef float f32x4 __attribute__((ext_vector_type(4)));
typedef unsigned u32x4 __attribute__((ext_vector_type(4)));
typedef unsigned u32x2 __attribute__((ext_vector_type(2)));

constexpr int NPROJ = 13568;
constexpr int C_RX = 0, C_RG = 1024, C_GQ = 2048, C_GZ = 5120, C_MQ = 6144, C_MG = 7168;
constexpr int NTHR = 512;
constexpr int LDS_BYTES = 137280;
constexpr int NPHASE = 9;

constexpr size_t O_Y = 0, O_MK = 18874368, O_MV = 19922944, O_RCP = 20971520, O_RHP = 20983808, O_GCP = 20987904, O_GSP = 21024768,
                 O_RCS = 21549056, O_RHS = 21942272, O_GCS = 22073344, O_GSS = 23252992;
constexpr size_t WS_SS1 = 4096, WS_SS2 = 40960, WS_DEC = 77824, WS_GBA = 81920, WS_WIN = 1048576, WS_WMKV = 56623104, WS_WUPS = 65011712,
                 WS_WOUT = 77594624, WS_WUP = 85983232, WS_WDN = 119537664, WS_WRG = 153092096, WS_XN = 153616384, WS_MEMN = 191365120,
                 WS_MKB = 195559424, WS_MVB = 197656576, WS_YCAT = 199753728, WS_MERGED = 256376832, WS_GP = 294125568, WS_PROJ = 369623040,
                 WS_END = 619708416;

struct P { const float* in[32]; float* out; unsigned char* ws; int ph_lo, ph_hi, roles, pad; };

typedef __bf16 bf16v2_t __attribute__((ext_vector_type(2)));
typedef float f32v2_t __attribute__((ext_vector_type(2)));
__device__ __forceinline__ unsigned cvt_pk_bf16(float lo, float hi) { const f32v2_t v = {lo, hi}; const bf16v2_t b = __builtin_convertvector(v, bf16v2_t); return __builtin_bit_cast(unsigned, b); }
__device__ __forceinline__ bf16_t f2bf(float f) { return (bf16_t)(cvt_pk_bf16(f, 0.f) & 0xffffu); }
__device__ __forceinline__ float bf2f(bf16_t b) { return __uint_as_float(((unsigned)b) << 16); }
__device__ __forceinline__ float bf_lo(unsigned u) { return __uint_as_float(u << 16); }
__device__ __forceinline__ float bf_hi(unsigned u) { return __uint_as_float(u & 0xffff0000u); }
__device__ __forceinline__ float sigm(float x) { return __builtin_amdgcn_rcpf(1.f + __expf(-x)); }
__device__ __forceinline__ float siluf(float x) { return x * sigm(x); }
__device__ __forceinline__ float softplusf(float x) { return fmaxf(x, 0.f) + log1pf(__expf(-fabsf(x))); }
__device__ __forceinline__ float actf(float x, int act) {
    if (act == 1) { const float t = 1.5957691216f * (x + 0.044715f * x * x * x); return x * sigm(t); }
    if (act == 2) return x * sigm(x);
    return sigm(x);
}
__device__ __forceinline__ float DBGFIN(float x) { return x; }
#define LDS_BAR() do { asm volatile("s_waitcnt lgkmcnt(0)" ::: "memory"); __builtin_amdgcn_s_barrier(); asm volatile("" ::: "memory"); } while (0)
#define MFMA16(a, b, c) __builtin_amdgcn_mfma_f32_16x16x32_bf16((a), (b), (c), 0, 0, 0)

namespace pg8 {
constexpr int BM = 256, BK = 64, HALF = 128, HTB = HALF * BK * 2, STAGE_BYTES = 8 * HTB, NXCD = 8, WGM = 8;
__host__ __device__ __forceinline__ int lds_byte(int r, int c) { const int st = (r >> 4) * 2 + (c >> 5), rr = r & 15, cc = c & 31, ob = rr * 64 + cc * 2; return st * 1024 + (ob ^ (((ob >> 9) & 1) << 5)); }
__host__ __device__ __forceinline__ void stage_rc(int b, int& R, int& C) { const int st = b / 1024, sb = b % 1024, swz = sb ^ (((sb >> 9) & 1) << 5); R = (st >> 1) * 16 + swz / 64; C = (st & 1) * 32 + (swz % 64) / 2; }
__host__ __device__ __forceinline__ int perm32(int rho) { const int n = rho >> 4, i = rho & 15; return 8 * (i >> 2) + 4 * n + (i & 3); }
struct Unit { int pm, pn, k0; };
struct Gemm { const bf16_t* A; const bf16_t* Bt; int M, N, K; int ntu; };
struct StaticOrder {
    int nM, nN, nwg, G, c;
    __device__ void init(int M, int N, int G_, int c_) { nM = M / BM; nN = N / BM; nwg = nM * nN; G = G_; c = c_; }
    __device__ bool next(int i, Unit& u) const {
        const long L = (long)i * G + c; if (L >= nwg) return false;
        int wgid = (int)L; { const int q = nwg / NXCD, r = nwg % NXCD, xcd = wgid % NXCD, off = wgid / NXCD; wgid = (xcd < r ? xcd * (q + 1) : r * (q + 1) + (xcd - r) * q) + off; }
        const int nig = WGM * nN, gid = wgid / nig, fm = gid * WGM, gsz = (nM - fm) < WGM ? (nM - fm) : WGM;
        u.pm = fm + ((wgid % nig) % gsz); u.pn = (wgid % nig) / gsz; u.k0 = 0; return true;
    }
};
struct TripleOrder {
    int G, c;
    __device__ bool next(int i, Unit& u) const {
        const int tile = (i / 3) * G + c; if (tile >= 288) return false;
        const int br = i % 3; u.pm = br * 36 + (tile % 36); u.pn = br * 8 + (tile / 36); u.k0 = 0; return true;
    }
};

struct DownMain { int G, c; __device__ bool next(int i, Unit& u) const { const int L = i * G + c; if (L >= 256) return false; u.pm = L >> 3; u.pn = L & 7; u.k0 = 0; return true; } };
struct DownTail { int G, c; __device__ bool next(int i, Unit& u) const { const int L = i * G + c; if (L >= 256) return false; const int t = L >> 3; u.pm = 32 + (t >> 3); u.pn = t & 7; u.k0 = (L & 7) * 16; return true; } };

template <class Epi, class Sched>
__device__ __forceinline__ void gemm_phase(LAS unsigned char* lds, const Gemm g, const Sched& S, const Epi& E) {
    const int tid = threadIdx.x, wid = __builtin_amdgcn_readfirstlane(tid >> 6), lane = tid & 63, wr = wid >> 2, wc = wid & 3, fr = lane & 15, fq = lane >> 4;
    const int K = g.K, nt = g.ntu ? g.ntu : K / BK;
    unsigned voffA[2], voffB[2];
#pragma unroll
    for (int i = 0; i < 2; ++i) { int R, C; stage_rc(tid * 16 + i * 8192, R, C); const int Rb = Epi::PERM ? ((R & ~31) + perm32(R & 31)) : R;
        voffA[i] = (unsigned)(R * K + C) * 2u; voffB[i] = (unsigned)(Rb * K + C) * 2u; }
    const size_t kstep = (size_t)(BK * 2);
    const size_t hstep = (size_t)HALF * K * 2;
    const size_t tstep = 2 * hstep;
    const unsigned ldsw = (unsigned)wid * 1024u;
    const int aoff = lds_byte(wr * 64 + fr, fq * 8), boff = lds_byte(wc * 32 + fr, fq * 8);
#define PG8_SA(b, h) (((b) * 2 + (h)) * HTB)
#define PG8_SB(b, h) ((4 + (b) * 2 + (h)) * HTB)
#define PG8_STAGE(bufoff, gbase, voff) do { _Pragma("unroll") for (int _i = 0; _i < 2; ++_i) \
        __builtin_amdgcn_global_load_lds((const unsigned*)((const char*)(gbase) + (voff)[_i]), (LAS unsigned*)(lds + (bufoff) + ldsw + _i * 8192), 16, 0, 0); } while (0)
#define PG8_LDA(dst, b, h) do { _Pragma("unroll") for (int m = 0; m < 4; ++m) _Pragma("unroll") for (int k = 0; k < 2; ++k) dst[m][k] = *(const LAS bf16x8*)(lds + PG8_SA(b, h) + aoff + m * 2048 + k * 1024); } while (0)
#define PG8_LDB(dst, b, h) do { _Pragma("unroll") for (int n = 0; n < 2; ++n) _Pragma("unroll") for (int k = 0; k < 2; ++k) dst[n][k] = *(const LAS bf16x8*)(lds + PG8_SB(b, h) + boff + n * 2048 + k * 1024); } while (0)
#define PG8_MMA(ai, bj, At, Bt) do { __builtin_amdgcn_s_setprio(1); _Pragma("unroll") for (int m = 0; m < 4; ++m) _Pragma("unroll") for (int n = 0; n < 2; ++n) _Pragma("unroll") for (int k = 0; k < 2; ++k) \
        acc[ai][bj][m][n] = __builtin_amdgcn_mfma_f32_16x16x32_bf16(Bt[n][k], At[m][k], acc[ai][bj][m][n], 0, 0, 0); __builtin_amdgcn_s_setprio(0); } while (0)
#define PG8_WAIT_V(n) asm volatile("s_waitcnt vmcnt(" #n ")" ::: "memory")
#define PG8_WAIT_L(n) asm volatile("s_waitcnt lgkmcnt(" #n ")" ::: "memory")
#define PG8_BAR __builtin_amdgcn_s_barrier()
#define PG8_SCHED __builtin_amdgcn_sched_barrier(0)
    Unit cur, nxt; int ui = 0;
    if (!S.next(0, cur)) return;
    f32x4 acc[2][2][4][2];
#pragma unroll
    for (int a = 0; a < 2; ++a)
#pragma unroll
        for (int b = 0; b < 2; ++b)
#pragma unroll
            for (int m = 0; m < 4; ++m)
#pragma unroll
                for (int n = 0; n < 2; ++n) acc[a][b][m][n] = (f32x4){0.f, 0.f, 0.f, 0.f};
    bf16x8 At[4][2], B0[2][2], B1[2][2];
    const char* cA = (const char*)g.A + (size_t)cur.pm * tstep + (size_t)cur.k0 * (BK * 2); const char* cB = (const char*)g.Bt + (size_t)cur.pn * tstep + (size_t)cur.k0 * (BK * 2);
    PG8_STAGE(PG8_SB(0, 0), cB, voffB); PG8_STAGE(PG8_SA(0, 0), cA, voffA); PG8_STAGE(PG8_SB(0, 1), cB + hstep, voffB); PG8_STAGE(PG8_SA(0, 1), cA + hstep, voffA);
    if (wr == 1) PG8_BAR;
    PG8_WAIT_V(4); PG8_BAR;
    PG8_STAGE(PG8_SB(1, 0), cB + kstep, voffB); PG8_STAGE(PG8_SA(1, 0), cA + kstep, voffA); PG8_STAGE(PG8_SB(1, 1), cB + hstep + kstep, voffB);
    PG8_WAIT_V(6); PG8_BAR;
    for (;;) {
        const bool has_next = S.next(ui + 1, nxt);
        const char* nA = has_next ? (const char*)g.A + (size_t)nxt.pm * tstep + (size_t)nxt.k0 * (BK * 2) : cA; const char* nB = has_next ? (const char*)g.Bt + (size_t)nxt.pn * tstep + (size_t)nxt.k0 * (BK * 2) : cB;
        for (int t = 0; t < nt; t += 2) {
            const bool last = (t == nt - 2);
            const char* a1 = cA + (size_t)(t + 1) * kstep;
            const char* a2 = last ? nA : cA + (size_t)(t + 2) * kstep; const char* b2 = last ? nB : cB + (size_t)(t + 2) * kstep;
            const char* a3 = a2 + kstep; const char* b3 = b2 + kstep;
            PG8_LDB(B0, 0, 0); PG8_SCHED; PG8_LDA(At, 0, 0); PG8_STAGE(PG8_SA(1, 1), a1 + hstep, voffA);
            PG8_WAIT_L(8); PG8_BAR; PG8_WAIT_L(0); PG8_MMA(0, 0, At, B0); PG8_BAR; PG8_SCHED;
            PG8_LDB(B1, 0, 1); PG8_STAGE(PG8_SB(0, 0), b2, voffB);
            PG8_BAR; PG8_WAIT_L(0); PG8_MMA(0, 1, At, B1); PG8_BAR;
            PG8_LDA(At, 0, 1); PG8_STAGE(PG8_SA(0, 0), a2, voffA);
            PG8_BAR; PG8_WAIT_L(0); PG8_MMA(1, 0, At, B0); PG8_BAR; PG8_SCHED;
            PG8_STAGE(PG8_SB(0, 1), b2 + hstep, voffB);
            PG8_WAIT_V(6); PG8_BAR; PG8_MMA(1, 1, At, B1); PG8_BAR;
            PG8_LDB(B0, 1, 0); PG8_SCHED; PG8_LDA(At, 1, 0); PG8_STAGE(PG8_SA(0, 1), a2 + hstep, voffA);
            PG8_WAIT_L(8); PG8_BAR; PG8_WAIT_L(0); PG8_MMA(0, 0, At, B0); PG8_BAR; PG8_SCHED;
            PG8_LDB(B1, 1, 1); PG8_STAGE(PG8_SB(1, 0), b3, voffB);
            PG8_BAR; PG8_WAIT_L(0); PG8_MMA(0, 1, At, B1); PG8_BAR;
            PG8_LDA(At, 1, 1); PG8_STAGE(PG8_SA(1, 0), a3, voffA);
            PG8_BAR; PG8_WAIT_L(0); PG8_MMA(1, 0, At, B0); PG8_BAR; PG8_SCHED;
            PG8_STAGE(PG8_SB(1, 1), b3 + hstep, voffB);
            PG8_WAIT_V(6); PG8_BAR; PG8_MMA(1, 1, At, B1); PG8_BAR;
        }
        E(acc, cur, wr, wc, fr, fq);
        if (!has_next) break;
#pragma unroll
        for (int a = 0; a < 2; ++a)
#pragma unroll
            for (int b = 0; b < 2; ++b)
#pragma unroll
                for (int m = 0; m < 4; ++m)
#pragma unroll
                    for (int n = 0; n < 2; ++n) acc[a][b][m][n] = (f32x4){0.f, 0.f, 0.f, 0.f};
        cur = nxt; cA = nA; cB = nB; ++ui;
    }
    PG8_WAIT_V(0);
    if (wr == 0) PG8_BAR;
    PG8_BAR;
#undef PG8_SA
#undef PG8_SB
#undef PG8_STAGE
#undef PG8_LDA
#undef PG8_LDB
#undef PG8_MMA
#undef PG8_WAIT_V
#undef PG8_WAIT_L
#undef PG8_BAR
#undef PG8_SCHED
}

typedef f32x4 Acc[2][2][4][2];

struct EpiProj {
    static constexpr bool PERM = true;
    bf16_t* O; float* gba;
    __device__ __forceinline__ void operator()(const Acc& acc, const Unit& u, int wr, int wc, int fr, int fq) const {
        const int row0 = u.pm * BM + wr * 64 + fr, col0 = u.pn * BM + wc * 32 + 8 * fq;
        const int pn = u.pn; const int act = (pn >= 4 && pn < 8) ? 1 : (pn >= 20 && pn < 24) ? 2 : (pn >= 28 && pn < 52) ? 3 : 0;
#pragma unroll
        for (int ai = 0; ai < 2; ++ai)
#pragma unroll
            for (int m = 0; m < 4; ++m) { bf16_t* rowp = O + (size_t)(row0 + ai * HALF + m * 16) * NPROJ + col0;
#pragma unroll
                for (int bj = 0; bj < 2; ++bj) { f32x4 v0 = acc[ai][bj][m][0], v1 = acc[ai][bj][m][1];
                    if (act) {
#pragma unroll
                        for (int j = 0; j < 4; ++j) { v0[j] = actf(v0[j], act); v1[j] = actf(v1[j], act); } }
                    u32x4 w; w.x = cvt_pk_bf16(v0[0], v0[1]); w.y = cvt_pk_bf16(v0[2], v0[3]); w.z = cvt_pk_bf16(v1[0], v1[1]); w.w = cvt_pk_bf16(v1[2], v1[3]);
                    *(u32x4*)(rowp + bj * HALF) = w; } }
        if (pn == 52 && wc == 0 && fq < 2) {
#pragma unroll
            for (int ai = 0; ai < 2; ++ai)
#pragma unroll
                for (int m = 0; m < 4; ++m) { float* gp = gba + (size_t)(row0 + ai * HALF + m * 16) * 16 + 8 * fq;
                    *(f32x4*)gp = acc[ai][0][m][0]; *(f32x4*)(gp + 4) = acc[ai][0][m][1]; } }
    }
};
struct EpiMemKV {
    static constexpr bool PERM = true;
    float* outk; float* outv; bf16_t* kb; bf16_t* vb;
    __device__ __forceinline__ void operator()(const Acc& acc, const Unit& u, int wr, int wc, int fr, int fq) const {
        const int row0 = u.pm * BM + wr * 64 + fr; const bool isv = u.pn >= 4; const int col0 = (u.pn & 3) * BM + wc * 32 + 8 * fq;
        float* of = isv ? outv : outk; bf16_t* ob = isv ? vb : kb;
#pragma unroll
        for (int ai = 0; ai < 2; ++ai)
#pragma unroll
            for (int m = 0; m < 4; ++m) { const size_t ro = (size_t)(row0 + ai * HALF + m * 16) * 1024 + col0;
#pragma unroll
                for (int bj = 0; bj < 2; ++bj) { const f32x4 v0 = acc[ai][bj][m][0], v1 = acc[ai][bj][m][1];
                    *(f32x4*)(of + ro + bj * HALF) = v0; *(f32x4*)(of + ro + bj * HALF + 4) = v1;
                    u32x4 w; w.x = cvt_pk_bf16(v0[0], v0[1]); w.y = cvt_pk_bf16(v0[2], v0[3]); w.z = cvt_pk_bf16(v1[0], v1[1]); w.w = cvt_pk_bf16(v1[2], v1[3]);
                    *(u32x4*)(ob + ro + bj * HALF) = w; } }
    }
};
struct EpiMerge {
    static constexpr bool PERM = true;
    const bf16_t* proj; float* mf; bf16_t* merged;
    __device__ __forceinline__ void operator()(const Acc& acc, const Unit& u, int wr, int wc, int fr, int fq) const {
        const int br = u.pm / 36, pm = u.pm - br * 36, pn = u.pn & 7;
        const int row0 = pm * BM + wr * 64 + fr, col0 = pn * BM + wc * 32 + 8 * fq;
#pragma unroll
        for (int ai = 0; ai < 2; ++ai)
#pragma unroll
            for (int m = 0; m < 4; ++m) { const size_t row = (size_t)(row0 + ai * HALF + m * 16);
#pragma unroll
                for (int bj = 0; bj < 2; ++bj) { const int col = col0 + bj * HALF;
                    const u32x4 gw = *(const u32x4*)(proj + row * NPROJ + C_MG + br * 2048 + col);
                    f32x4 v0 = acc[ai][bj][m][0], v1 = acc[ai][bj][m][1];
                    v0[0] *= bf_lo(gw.x); v0[1] *= bf_hi(gw.x); v0[2] *= bf_lo(gw.y); v0[3] *= bf_hi(gw.y);
                    v1[0] *= bf_lo(gw.z); v1[1] *= bf_hi(gw.z); v1[2] *= bf_lo(gw.w); v1[3] *= bf_hi(gw.w);
                    bf16_t* mp = merged + row * 2048 + col;
                    if (br > 0) { const u32x4 pv = *(const u32x4*)mp; v0[0] += bf_lo(pv.x); v0[1] += bf_hi(pv.x); v0[2] += bf_lo(pv.y); v0[3] += bf_hi(pv.y);
                        v1[0] += bf_lo(pv.z); v1[1] += bf_hi(pv.z); v1[2] += bf_lo(pv.w); v1[3] += bf_hi(pv.w); }
                    { u32x4 w; w.x = cvt_pk_bf16(v0[0], v0[1]); w.y = cvt_pk_bf16(v0[2], v0[3]); w.z = cvt_pk_bf16(v1[0], v1[1]); w.w = cvt_pk_bf16(v1[2], v1[3]);
                        *(u32x4*)mp = w; } }
                asm volatile("" ::: "memory"); }
    }
};
struct EpiOut {
    static constexpr bool PERM = true;
    const float* xp; const float* xs; float* x1; bf16_t* x1b; float* ss;
    __device__ __forceinline__ void operator()(const Acc& acc, const Unit& u, int wr, int wc, int fr, int fq) const {
        const int row0 = u.pm * BM + wr * 64 + fr, col0 = u.pn * BM + wc * 32 + 8 * fq;
        const float* xb = (u.pm < 32) ? xp : xs - (size_t)8192 * 2048;
#pragma unroll
        for (int ai = 0; ai < 2; ++ai)
#pragma unroll
            for (int m = 0; m < 4; ++m) { const size_t row = (size_t)(row0 + ai * HALF + m * 16); float s = 0.f;
#pragma unroll
                for (int bj = 0; bj < 2; ++bj) { const size_t o = row * 2048 + col0 + bj * HALF;
                    const f32x4 v0 = acc[ai][bj][m][0] + *(const f32x4*)(xb + o), v1 = acc[ai][bj][m][1] + *(const f32x4*)(xb + o + 4);
                    s += v0[0] * v0[0] + v0[1] * v0[1] + v0[2] * v0[2] + v0[3] * v0[3] + v1[0] * v1[0] + v1[1] * v1[1] + v1[2] * v1[2] + v1[3] * v1[3];
                    u32x4 w; w.x = cvt_pk_bf16(v0[0], v0[1]); w.y = cvt_pk_bf16(v0[2], v0[3]); w.z = cvt_pk_bf16(v1[0], v1[1]); w.w = cvt_pk_bf16(v1[2], v1[3]);
                    *(u32x4*)(x1b + o) = w; }
                s += __shfl_xor(s, 16); s += __shfl_xor(s, 32);
                if (fq == 0) atomicAdd(ss + row, s); }
    }
};
struct EpiUp {
    static constexpr bool PERM = true;
    const float* ss; bf16_t* hid;
    __device__ __forceinline__ void operator()(const Acc& acc, const Unit& u, int wr, int wc, int fr, int fq) const {
        const int row0 = u.pm * BM + wr * 64 + fr, col0 = u.pn * BM + wc * 32 + 8 * fq;
#pragma unroll
        for (int ai = 0; ai < 2; ++ai)
#pragma unroll
            for (int m = 0; m < 4; ++m) { const size_t row = (size_t)(row0 + ai * HALF + m * 16); const float rs = rsqrtf(ss[row] * (1.f / 2048.f) + 1e-6f);
#pragma unroll
                for (int bj = 0; bj < 2; ++bj) { f32x4 v0 = acc[ai][bj][m][0] * rs, v1 = acc[ai][bj][m][1] * rs;
#pragma unroll
                    for (int j = 0; j < 4; ++j) { const float a = fmaxf(v0[j], 0.f), b = fmaxf(v1[j], 0.f); v0[j] = a * a; v1[j] = b * b; }
                    u32x4 w; w.x = cvt_pk_bf16(v0[0], v0[1]); w.y = cvt_pk_bf16(v0[2], v0[3]); w.z = cvt_pk_bf16(v1[0], v1[1]); w.w = cvt_pk_bf16(v1[2], v1[3]);
                    *(u32x4*)(hid + row * 8192 + col0 + bj * HALF) = w; } }
    }
};
struct EpiDown {
    static constexpr bool PERM = false;
    float* x; const bf16_t* x1b;
    __device__ __forceinline__ void operator()(const Acc& acc, const Unit& u, int wr, int wc, int fr, int fq) const {
        const int row0 = u.pm * BM + wr * 64 + fr, col0 = u.pn * BM + wc * 32 + 4 * fq;
#pragma unroll
        for (int ai = 0; ai < 2; ++ai)
#pragma unroll
            for (int m = 0; m < 4; ++m) { const size_t ro = (size_t)(row0 + ai * HALF + m * 16) * 2048 + col0;
#pragma unroll
                for (int bj = 0; bj < 2; ++bj)
#pragma unroll
                    for (int n = 0; n < 2; ++n) { const size_t o = ro + bj * HALF + n * 16; const u32x2 r = *(const u32x2*)(x1b + o);
                        f32x4 v = acc[ai][bj][m][n]; v[0] += bf_lo(r.x); v[1] += bf_hi(r.x); v[2] += bf_lo(r.y); v[3] += bf_hi(r.y); *(f32x4*)(x + o) = v; } }
    }
};
struct EpiDownPart {
    static constexpr bool PERM = false;
    bf16_t* part;
    __device__ __forceinline__ void operator()(const Acc& acc, const Unit& u, int wr, int wc, int fr, int fq) const {
        const int row0 = (u.pm - 32) * BM + wr * 64 + fr, col0 = u.pn * BM + wc * 32 + 4 * fq; bf16_t* pb = part + (size_t)(u.k0 >> 4) * 1024 * 2048;
#pragma unroll
        for (int ai = 0; ai < 2; ++ai)
#pragma unroll
            for (int m = 0; m < 4; ++m) { bf16_t* rowp = pb + (size_t)(row0 + ai * HALF + m * 16) * 2048 + col0;
#pragma unroll
                for (int bj = 0; bj < 2; ++bj)
#pragma unroll
                    for (int n = 0; n < 2; ++n) { const f32x4 v = acc[ai][bj][m][n]; u32x2 w; w.x = cvt_pk_bf16(v[0], v[1]); w.y = cvt_pk_bf16(v[2], v[3]); *(u32x2*)(rowp + bj * HALF + n * 16) = w; } }
    }
};
}

__device__ __forceinline__ int win_map(int nd) { return nd < 6144 ? nd : (nd < 13312 ? nd + 16 : (nd < 13328 ? nd - 13312 + 6144 : -1)); }
__device__ __forceinline__ void tconv(LAS unsigned char* lds, const float* __restrict__ src, int K, int Nsrc, bf16_t* __restrict__ dst, int Ndst,
                                      const float* __restrict__ kscale, bool winmap, int& tbase, int bid, int G) {
    const int lane = threadIdx.x & 63, wid = threadIdx.x >> 6; const int ntk = K / 64, ntn = Ndst / 64, ntile = ntk * ntn;
    LAS float* T = (LAS float*)(lds + wid * 16640);
    const int W = G * 8, me = bid * 8 + wid;
    int first = (me - (tbase % W) + W) % W;
    for (int t = first; t < ntile; t += W) {
        const int tk = t % ntk, tn = t / ntk, k0 = tk * 64, n0 = tn * 64;
        f32x4 v[16];
#pragma unroll
        for (int i = 0; i < 16; ++i) { const int q = lane + 64 * i, kr = q >> 4, c4 = q & 15; const int nd = n0 + c4 * 4; const int ns = winmap ? win_map(nd) : nd;
            v[i] = (f32x4){0.f, 0.f, 0.f, 0.f};
            if (ns >= 0) v[i] = *(const f32x4*)(src + (size_t)(k0 + kr) * Nsrc + ns);
            if (kscale) v[i] *= kscale[k0 + kr]; }
#pragma unroll
        for (int i = 0; i < 16; ++i) { const int q = lane + 64 * i, kr = q >> 4, c4 = q & 15; LAS float* tp = T + kr * 65 + c4 * 4; tp[0] = v[i][0]; tp[1] = v[i][1]; tp[2] = v[i][2]; tp[3] = v[i][3]; }
        const int nl = lane >> 3, kg = lane & 7;
#pragma unroll
        for (int g = 0; g < 8; ++g) { const int nn = g * 8 + nl; float e[8];
#pragma unroll
            for (int j = 0; j < 8; ++j) e[j] = T[(kg * 8 + j) * 65 + nn];
            u32x4 w; w.x = cvt_pk_bf16(e[0], e[1]); w.y = cvt_pk_bf16(e[2], e[3]); w.z = cvt_pk_bf16(e[4], e[5]); w.w = cvt_pk_bf16(e[6], e[7]);
            *(u32x4*)(dst + (size_t)(n0 + nn) * K + k0 + kg * 8) = w; }
    }
    tbase += ntile;
}
__device__ __forceinline__ void phase0(LAS unsigned char* lds, const P& p, int bid, int G) {
    unsigned char* ws = p.ws; const int tid = threadIdx.x, lane = tid & 63, wid = tid >> 6;
    if (bid == 0 && tid == 0) ((unsigned*)ws)[16] = 0u;
    for (int i = bid * NTHR + tid; i < 2 * 9216; i += G * NTHR) ((float*)(ws + WS_SS1))[i] = 0.f;
    for (int row = bid * 8 + wid; row < 10240; row += G * 8) {
        const float* src = row < 8192 ? p.in[0] + (size_t)row * 2048 : (row < 9216 ? p.in[1] + (size_t)(row - 8192) * 2048 : p.in[2] + (size_t)(row - 9216) * 2048);
        const float* g = row < 9216 ? p.in[9] : p.in[22];
        bf16_t* dst = row < 9216 ? (bf16_t*)(ws + WS_XN) + (size_t)row * 2048 : (bf16_t*)(ws + WS_MEMN) + (size_t)(row - 9216) * 2048;
        f32x4 v[8]; float s = 0.f;
#pragma unroll
        for (int i = 0; i < 8; ++i) { v[i] = *(const f32x4*)(src + (i * 64 + lane) * 4); s += v[i][0] * v[i][0] + v[i][1] * v[i][1] + v[i][2] * v[i][2] + v[i][3] * v[i][3]; }
#pragma unroll
        for (int o = 32; o >= 1; o >>= 1) s += __shfl_xor(s, o);
        const float rs = rsqrtf(s * (1.f / 2048.f) + 1e-6f);
#pragma unroll
        for (int i = 0; i < 8; ++i) { const f32x4 gg = *(const f32x4*)(g + (i * 64 + lane) * 4); const f32x4 y = v[i] * rs * gg;
            u32x2 w; w.x = cvt_pk_bf16(y[0], y[1]); w.y = cvt_pk_bf16(y[2], y[3]); *(u32x2*)(dst + (i * 64 + lane) * 4) = w; }
    }
    int tb = 0;
    tconv(lds, p.in[10], 2048, 13328, (bf16_t*)(ws + WS_WIN), 13568, nullptr, true, tb, bid, G);
    tconv(lds, p.in[23], 2048, 2048, (bf16_t*)(ws + WS_WMKV), 2048, nullptr, false, tb, bid, G);
    tconv(lds, p.in[24], 1024, 2048, (bf16_t*)(ws + WS_WUPS), 2048, nullptr, false, tb, bid, G);
    tconv(lds, p.in[25], 1024, 2048, (bf16_t*)(ws + WS_WUPS) + (size_t)2048 * 1024, 2048, nullptr, false, tb, bid, G);
    tconv(lds, p.in[26], 1024, 2048, (bf16_t*)(ws + WS_WUPS) + (size_t)2 * 2048 * 1024, 2048, nullptr, false, tb, bid, G);
    tconv(lds, p.in[27], 2048, 2048, (bf16_t*)(ws + WS_WOUT), 2048, nullptr, false, tb, bid, G);
    tconv(lds, p.in[29], 2048, 8192, (bf16_t*)(ws + WS_WUP), 8192, p.in[28], false, tb, bid, G);
    tconv(lds, p.in[30], 8192, 2048, (bf16_t*)(ws + WS_WDN), 2048, nullptr, false, tb, bid, G);
    for (int nb = 0; nb < 8; ++nb) {
        tconv(lds, p.in[13] + (size_t)nb * 16384, 128, 128, (bf16_t*)(ws + WS_WRG) + (size_t)nb * 32768, 128, nullptr, false, tb, bid, G);
        tconv(lds, p.in[15] + (size_t)nb * 16384, 128, 128, (bf16_t*)(ws + WS_WRG) + (size_t)nb * 32768 + 16384, 128, nullptr, false, tb, bid, G);
    }
}

constexpr int GPC = 36864;
__device__ __forceinline__ void gdn_prep_item(LAS unsigned char* lds, const P& p, int item) {
    const int tid = threadIdx.x, lane = tid & 63, wid = __builtin_amdgcn_readfirstlane(tid >> 6), fr = lane & 15, fq = lane >> 4;
    const int c = item & 31, h = (item >> 5) & 7, b = item >> 8;
    const int tok0 = b * 2048 + c * 64;
    const bf16_t* PROJ = (const bf16_t*)(p.ws + WS_PROJ); const float* GBA = (const float*)(p.ws + WS_GBA);
    bf16_t* gp = (bf16_t*)(p.ws + WS_GP) + (size_t)item * GPC;
    LAS bf16_t* qs = (LAS bf16_t*)(lds + 0);
    LAS bf16_t* ks = (LAS bf16_t*)(lds + 17408);
    LAS bf16_t* vs = (LAS bf16_t*)(lds + 34816);
    LAS float* Mf = (LAS float*)(lds + 52224);
    LAS float* sc = (LAS float*)(lds + 114688);
    __syncthreads();
    if (wid == 0) {
        const float gb = GBA[(size_t)(tok0 + lane) * 16 + h], ga = GBA[(size_t)(tok0 + lane) * 16 + 8 + h];
        const float beta = sigm(gb);
        const float g = -__expf(p.in[19][h]) * softplusf(ga + p.in[20][h]);
        float gc = g;
#pragma unroll
        for (int o = 1; o < 64; o <<= 1) { const float t = __shfl_up(gc, o); if (lane >= o) gc += t; }
        const float gl = __shfl(gc, 63);
        sc[lane] = gc; sc[64 + lane] = beta; sc[128 + lane] = __expf(gc); sc[192 + lane] = __expf(gl - gc); sc[256 + lane] = beta * __expf(gc);
        if (lane == 0) ((float*)(p.ws + WS_DEC))[item] = __expf(gl);
    }
    {
        const int r = tid >> 3, seg = tid & 7;
#pragma unroll
        for (int mat = 0; mat < 3; ++mat) {
            const int chm = mat * 1024 + h * 128 + seg * 16;
            float a[16];
#pragma unroll
            for (int i = 0; i < 16; ++i) a[i] = 0.f;
#pragma unroll
            for (int j = 0; j < 4; ++j) { const int t = c * 64 + r - 3 + j;
                if (t >= 0) { const bf16_t* src = PROJ + (size_t)(b * 2048 + t) * NPROJ + C_GQ + chm; const u32x4 x0 = *(const u32x4*)src, x1 = *(const u32x4*)(src + 8);
                    const float* w = p.in[18] + j * 3072 + chm; const f32x4 w0 = *(const f32x4*)w, w1 = *(const f32x4*)(w + 4), w2 = *(const f32x4*)(w + 8), w3 = *(const f32x4*)(w + 12);
                    a[0] += w0[0] * bf_lo(x0.x); a[1] += w0[1] * bf_hi(x0.x); a[2] += w0[2] * bf_lo(x0.y); a[3] += w0[3] * bf_hi(x0.y);
                    a[4] += w1[0] * bf_lo(x0.z); a[5] += w1[1] * bf_hi(x0.z); a[6] += w1[2] * bf_lo(x0.w); a[7] += w1[3] * bf_hi(x0.w);
                    a[8] += w2[0] * bf_lo(x1.x); a[9] += w2[1] * bf_hi(x1.x); a[10] += w2[2] * bf_lo(x1.y); a[11] += w2[3] * bf_hi(x1.y);
                    a[12] += w3[0] * bf_lo(x1.z); a[13] += w3[1] * bf_hi(x1.z); a[14] += w3[2] * bf_lo(x1.w); a[15] += w3[3] * bf_hi(x1.w); } }
            float ss = 0.f;
#pragma unroll
            for (int i = 0; i < 16; ++i) { a[i] = siluf(a[i]); ss += a[i] * a[i]; }
            if (mat < 2) { ss += __shfl_xor(ss, 1); ss += __shfl_xor(ss, 2); ss += __shfl_xor(ss, 4);
                float rn = rsqrtf(ss + 1e-6f); if (mat == 0) rn *= 0.08838834764831845f;
#pragma unroll
                for (int i = 0; i < 16; ++i) a[i] *= rn; }
            LAS bf16_t* dst = (mat == 0 ? qs : (mat == 1 ? ks : vs)) + r * 136 + seg * 16;
            u32x4 w0, w1; w0.x = cvt_pk_bf16(a[0], a[1]); w0.y = cvt_pk_bf16(a[2], a[3]); w0.z = cvt_pk_bf16(a[4], a[5]); w0.w = cvt_pk_bf16(a[6], a[7]);
            w1.x = cvt_pk_bf16(a[8], a[9]); w1.y = cvt_pk_bf16(a[10], a[11]); w1.z = cvt_pk_bf16(a[12], a[13]); w1.w = cvt_pk_bf16(a[14], a[15]);
            *(LAS u32x4*)dst = w0; *(LAS u32x4*)(dst + 8) = w1;
        }
    }
    LDS_BAR();
    {
        const int r = tid & 63, seg = tid >> 6; const float ed = sc[192 + r];
        bf16_t* kdt = gp + 24576;
#pragma unroll
        for (int i = 0; i < 16; ++i) { const int ch = seg * 16 + i; const float kv = bf2f(ks[r * 136 + ch]);
            kdt[ch * 64 + r] = f2bf(kv * ed); }
    }
    {
        const int r = tid >> 3, seg = tid & 7; const float eg = sc[128 + r];
        const u32x4 x0 = *(const LAS u32x4*)(qs + r * 136 + seg * 16), x1 = *(const LAS u32x4*)(qs + r * 136 + seg * 16 + 8);
        u32x4 w0, w1;
        w0.x = cvt_pk_bf16(bf_lo(x0.x) * eg, bf_hi(x0.x) * eg); w0.y = cvt_pk_bf16(bf_lo(x0.y) * eg, bf_hi(x0.y) * eg); w0.z = cvt_pk_bf16(bf_lo(x0.z) * eg, bf_hi(x0.z) * eg); w0.w = cvt_pk_bf16(bf_lo(x0.w) * eg, bf_hi(x0.w) * eg);
        w1.x = cvt_pk_bf16(bf_lo(x1.x) * eg, bf_hi(x1.x) * eg); w1.y = cvt_pk_bf16(bf_lo(x1.y) * eg, bf_hi(x1.y) * eg); w1.z = cvt_pk_bf16(bf_lo(x1.z) * eg, bf_hi(x1.z) * eg); w1.w = cvt_pk_bf16(bf_lo(x1.w) * eg, bf_hi(x1.w) * eg);
        bf16_t* d = gp + 8192 + r * 128 + seg * 16; *(u32x4*)d = w0; *(u32x4*)(d + 8) = w1;
    }
    {
        bf16_t* at = gp + 32768;
#pragma unroll
        for (int i4 = 0; i4 < 4; ++i4) { const int T = wid * 4 + i4, which = T >> 4, it = (T >> 2) & 3, jt = T & 3;
            if (jt <= it) {
                f32x4 acc = (f32x4){0.f, 0.f, 0.f, 0.f}; const LAS bf16_t* A = which ? qs : ks;
                bf16x8 fa[4], fb[4];
#pragma unroll
                for (int k = 0; k < 4; ++k) { fa[k] = *(const LAS bf16x8*)(A + (16 * it + fr) * 136 + 32 * k + fq * 8); fb[k] = *(const LAS bf16x8*)(ks + (16 * jt + fr) * 136 + 32 * k + fq * 8); }
#pragma unroll
                for (int k = 0; k < 4; ++k) acc = MFMA16(fa[k], fb[k], acc);
#pragma unroll
                for (int r = 0; r < 4; ++r) { const int i = 16 * it + fq * 4 + r, j = 16 * jt + fr; const float d = (j <= i) ? __expf(sc[i] - sc[j]) : 0.f;
                    if (!which) { if (j < i) Mf[i * 64 + j] = sc[64 + i] * acc[r] * d; }
                    else at[i * 64 + j] = f2bf(acc[r] * d); }
            } else if (which) {
#pragma unroll
                for (int r = 0; r < 4; ++r) at[(16 * it + fq * 4 + r) * 64 + 16 * jt + fr] = (bf16_t)0;
            }
        }
    }
    LDS_BAR();
    if (wid < 4) {
        const bool isk = wid >= 2; const int col = (wid & 1) * 64 + lane;
        float X[64]; int zoff; asm volatile("v_mov_b32 %0, 0" : "=v"(zoff)); const LAS float* Mz = Mf + zoff; const LAS float* scz = sc + zoff + (isk ? 256 : 64);
        const LAS bf16_t* src = (const LAS bf16_t*)(lds + (isk ? 17408 : 34816)) + col + zoff;
#pragma unroll
        for (int i = 0; i < 64; ++i) {
            f32x4 mrow[(i + 3) / 4 > 0 ? (i + 3) / 4 : 1];
#pragma unroll
            for (int v = 0; v < (i + 3) / 4; ++v) mrow[v] = *(const LAS f32x4*)(Mz + i * 64 + 4 * v);
            float a0 = bf2f(src[i * 136]) * scz[i], a1 = 0.f, a2 = 0.f, a3 = 0.f;
#pragma unroll
            for (int j = 0; j < i; ++j) { const float mv = mrow[j >> 2][j & 3];
                if ((j & 3) == 0) a0 -= mv * X[j]; else if ((j & 3) == 1) a1 -= mv * X[j]; else if ((j & 3) == 2) a2 -= mv * X[j]; else a3 -= mv * X[j]; }
            X[i] = (a0 + a1) + (a2 + a3);
            asm volatile("" ::: "memory");
        }
        if (!isk) {
            bf16_t* d = gp + 16384 + col * 64;
#pragma unroll
            for (int e = 0; e < 8; ++e) { u32x4 w; w.x = cvt_pk_bf16(X[8 * e], X[8 * e + 1]); w.y = cvt_pk_bf16(X[8 * e + 2], X[8 * e + 3]); w.z = cvt_pk_bf16(X[8 * e + 4], X[8 * e + 5]); w.w = cvt_pk_bf16(X[8 * e + 6], X[8 * e + 7]);
                *(u32x4*)(d + 8 * e) = w; }
        } else {
#pragma unroll
            for (int i = 0; i < 64; ++i) gp[i * 128 + col] = f2bf(X[i]);
        }
    }
}

__device__ __forceinline__ void gdn_seq_item(LAS unsigned char* lds, const P& p, int item) {
    const int tid = threadIdx.x, lane = tid & 63, wid = __builtin_amdgcn_readfirstlane(tid >> 6), fr = lane & 15, fq = lane >> 4;
    const int b = item >> 3, h = item & 7;
    const bf16_t* gp = (const bf16_t*)(p.ws + WS_GP) + (size_t)item * 32 * GPC;
    const float* DEC = (const float*)(p.ws + WS_DEC) + item * 32;
    const bf16_t* PROJ = (const bf16_t*)(p.ws + WS_PROJ);
    bf16_t* YG = (bf16_t*)(p.ws + WS_YCAT) + (size_t)9216 * 1024;
    LAS bf16_t* KCD = (LAS bf16_t*)(lds + 0);
    LAS bf16_t* QG = (LAS bf16_t*)(lds + 17408);
    LAS bf16_t* VT = (LAS bf16_t*)(lds + 34816);
    LAS bf16_t* KDT = (LAS bf16_t*)(lds + 53248);
    LAS bf16_t* AT = (LAS bf16_t*)(lds + 71680);
    LAS bf16_t* ST = (LAS bf16_t*)(lds + 80896);
    LAS bf16_t* VNT = (LAS bf16_t*)(lds + 115712);
    LAS float* SSQ = (LAS float*)(lds + 134144);
#if DBG_SEQ_SUM
    { float* so = p.out + O_GSP + (size_t)item * 16384;
      for (int e = tid; e < 16384; e += NTHR) { const int dk = e >> 7, dv = e & 127; float a = 0.f;
          for (int c = 0; c < 32; ++c) { const bf16_t* g = gp + (size_t)c * GPC; a += bf2f(g[(dk & 63) * 128 + dv]) + bf2f(g[16384 + dv * 64 + (dk & 63)]) + bf2f(g[8192 + (dk & 63) * 128 + dv]) + bf2f(g[24576 + dv * 64 + (dk & 63)]) + bf2f(g[32768 + (dk & 63) * 64 + (dv & 63)]) + DEC[c]; }
          so[e] = a; }
      for (int e = tid; e < 2048 * 128; e += NTHR) YG[((size_t)b * 2048 + (e >> 7)) * 1024 + h * 128 + (e & 127)] = 0;
      return; }
#endif
    u32x4 pf[9];
#define GS_LOAD(cc) do { _Pragma("unroll") for (int i = 0; i < 9; ++i) pf[i] = *(const u32x4*)(gp + (size_t)(cc) * GPC + (size_t)(tid + NTHR * i) * 8); } while (0)
#define GS_STORE() do { _Pragma("unroll") for (int i = 0; i < 9; ++i) { const int q = tid + NTHR * i; int off; \
        if (i < 2) off = 0 + (q >> 4) * 272 + (q & 15) * 16; else if (i < 4) off = 17408 + ((q - 1024) >> 4) * 272 + (q & 15) * 16; \
        else if (i < 6) off = 34816 + ((q - 2048) >> 3) * 144 + (q & 7) * 16; else if (i < 8) off = 53248 + ((q - 3072) >> 3) * 144 + (q & 7) * 16; \
        else off = 71680 + ((q - 4096) >> 3) * 144 + (q & 7) * 16; \
        *(LAS u32x4*)(lds + off) = pf[i]; } } while (0)
    __syncthreads();
    GS_LOAD(0);
    for (int i = tid; i < 34816 / 16; i += NTHR) *(LAS u32x4*)(lds + 80896 + i * 16) = (u32x4){0u, 0u, 0u, 0u};
    GS_STORE();
    f32x4 Sacc[8];
#pragma unroll
    for (int i = 0; i < 8; ++i) Sacc[i] = (f32x4){0.f, 0.f, 0.f, 0.f};
    __syncthreads();
    const int it = wid & 3, dvb = (wid >> 2) * 4;
    for (int c = 0; c < 32; ++c) {
        if (c + 1 < 32) GS_LOAD(c + 1);
        const float dec = DEC[c];
        u32x2 zpf[4];
        { const size_t gt = (size_t)b * 2048 + c * 64 + 16 * it + fr;
#pragma unroll
          for (int q = 0; q < 4; ++q) zpf[q] = *(const u32x2*)(PROJ + gt * NPROJ + C_GZ + h * 128 + 16 * (dvb + q) + fq * 4); }
        {
            bf16x8 a[4];
#pragma unroll
            for (int k = 0; k < 4; ++k) a[k] = *(const LAS bf16x8*)(KCD + (16 * it + fr) * 136 + 32 * k + fq * 8);
            bf16x8 sb[4][4]; u32x2 vvq[4];
#pragma unroll
            for (int q = 0; q < 4; ++q) {
#pragma unroll
                for (int k = 0; k < 4; ++k) sb[q][k] = *(const LAS bf16x8*)(ST + (16 * (dvb + q) + fr) * 136 + 32 * k + fq * 8);
                vvq[q] = *(const LAS u32x2*)(VT + (16 * (dvb + q) + fr) * 72 + 16 * it + fq * 4); }
#pragma unroll
            for (int q = 0; q < 4; ++q) { const int dvt = dvb + q; f32x4 acc = (f32x4){0.f, 0.f, 0.f, 0.f};
#pragma unroll
                for (int k = 0; k < 4; ++k) acc = MFMA16(a[k], sb[q][k], acc);
                const u32x2 vv = vvq[q];
                u32x2 w; w.x = cvt_pk_bf16(bf_lo(vv.x) - acc[0], bf_hi(vv.x) - acc[1]); w.y = cvt_pk_bf16(bf_lo(vv.y) - acc[2], bf_hi(vv.y) - acc[3]);
                *(LAS u32x2*)(VNT + (16 * dvt + fr) * 72 + 16 * it + fq * 4) = w; }
        }
        LDS_BAR();
        f32x4 oacc[4];
        {
            bf16x8 bq[4], ba[2];
#pragma unroll
            for (int k = 0; k < 4; ++k) bq[k] = *(const LAS bf16x8*)(QG + (16 * it + fr) * 136 + 32 * k + fq * 8);
#pragma unroll
            for (int k = 0; k < 2; ++k) ba[k] = *(const LAS bf16x8*)(AT + (16 * it + fr) * 72 + 32 * k + fq * 8);
            float s = 0.f;
#pragma unroll
            for (int q2 = 0; q2 < 4; q2 += 2) {
              bf16x8 sa[2][4], va[2][2];
#pragma unroll
              for (int e = 0; e < 2; ++e) {
#pragma unroll
                for (int k = 0; k < 4; ++k) sa[e][k] = *(const LAS bf16x8*)(ST + (16 * (dvb + q2 + e) + fr) * 136 + 32 * k + fq * 8);
#pragma unroll
                for (int k = 0; k < 2; ++k) va[e][k] = *(const LAS bf16x8*)(VNT + (16 * (dvb + q2 + e) + fr) * 72 + 32 * k + fq * 8); }
#pragma unroll
              for (int e = 0; e < 2; ++e) { const int q = q2 + e; f32x4 acc = (f32x4){0.f, 0.f, 0.f, 0.f};
#pragma unroll
                for (int k = 0; k < 4; ++k) acc = MFMA16(sa[e][k], bq[k], acc);
#pragma unroll
                for (int k = 0; k < 2; ++k) acc = MFMA16(va[e][k], ba[k], acc);
                oacc[q] = acc; s += acc[0] * acc[0] + acc[1] * acc[1] + acc[2] * acc[2] + acc[3] * acc[3]; }
            }
            s += __shfl_xor(s, 16); s += __shfl_xor(s, 32);
            if (fq == 0) SSQ[(wid >> 2) * 64 + 16 * it + fr] = s;
        }
        {
            bf16x8 a[2];
#pragma unroll
            for (int k = 0; k < 2; ++k) a[k] = *(const LAS bf16x8*)(KDT + (16 * wid + fr) * 72 + 32 * k + fq * 8);
            bf16x8 vb[8][2];
#pragma unroll
            for (int dvt = 0; dvt < 8; ++dvt)
#pragma unroll
                for (int k = 0; k < 2; ++k) vb[dvt][k] = *(const LAS bf16x8*)(VNT + (16 * dvt + fr) * 72 + 32 * k + fq * 8);
#pragma unroll
            for (int dvt = 0; dvt < 8; ++dvt) { f32x4 acc = Sacc[dvt] * dec;
#pragma unroll
                for (int k = 0; k < 2; ++k) acc = MFMA16(a[k], vb[dvt][k], acc);
                Sacc[dvt] = acc; }
        }
        LDS_BAR();
        {
#pragma unroll
            for (int dvt = 0; dvt < 8; ++dvt) { u32x2 w; w.x = cvt_pk_bf16(Sacc[dvt][0], Sacc[dvt][1]); w.y = cvt_pk_bf16(Sacc[dvt][2], Sacc[dvt][3]);
                *(LAS u32x2*)(ST + (16 * dvt + fr) * 136 + 16 * wid + fq * 4) = w; }
            const float tot = SSQ[16 * it + fr] + SSQ[64 + 16 * it + fr]; const float rs = rsqrtf(tot * (1.f / 128.f) + 1e-6f);
            const size_t gtok = (size_t)b * 2048 + c * 64 + 16 * it + fr;
#pragma unroll
            for (int q = 0; q < 4; ++q) { const int dv = 16 * (dvb + q) + fq * 4;
                const u32x2 z = zpf[q]; const f32x4 gn = *(const f32x4*)(p.in[21] + dv);
                u32x2 w; w.x = cvt_pk_bf16(DBGFIN(oacc[q][0] * rs * gn[0] * bf_lo(z.x)), DBGFIN(oacc[q][1] * rs * gn[1] * bf_hi(z.x)));
                w.y = cvt_pk_bf16(DBGFIN(oacc[q][2] * rs * gn[2] * bf_lo(z.y)), DBGFIN(oacc[q][3] * rs * gn[3] * bf_hi(z.y)));
                *(u32x2*)(YG + gtok * 1024 + h * 128 + dv) = w; }
            if (c + 1 < 32) GS_STORE();
        }
        LDS_BAR();
    }
    {
        float* so = p.out + O_GSP + (size_t)item * 16384;
#pragma unroll
        for (int dvt = 0; dvt < 8; ++dvt)
#pragma unroll
            for (int r = 0; r < 4; ++r) so[(16 * wid + fq * 4 + r) * 128 + 16 * dvt + fr] = Sacc[dvt][r];
    }
#undef GS_LOAD
#undef GS_STORE
}

template <bool PROMPT>
__device__ __forceinline__ void rglru_item(LAS unsigned char* lds, const P& p, int item) {
    const int tid = threadIdx.x, lane = tid & 63, wid = __builtin_amdgcn_readfirstlane(tid >> 6), fr = lane & 15, fq = lane >> 4;
    const int q = item & 3, n = (item >> 2) & 7, bb0 = item >> 5;
    const int gq0 = n * 128 + 32 * q;
    const bf16_t* PROJ = (const bf16_t*)(p.ws + WS_PROJ);
    bf16_t* YR = (bf16_t*)(p.ws + WS_YCAT);
    LAS bf16_t* WL = (LAS bf16_t*)(lds + 0);
    LAS bf16_t* XA = (LAS bf16_t*)(lds + 17408);
    LAS bf16_t* RG = (LAS bf16_t*)(lds + 52224);
    LAS float* WT = (LAS float*)(lds + 62464);
    LAS float* HC = (LAS float*)(lds + 64512);
    LAS float* PAR = (LAS float*)(lds + 64768);
    __syncthreads();
    {   const bf16_t* wsrc = (const bf16_t*)(p.ws + WS_WRG) + (size_t)n * 32768;
#pragma unroll
        for (int i = 0; i < 2; ++i) { const int c = tid + NTHR * i, r = c >> 4, c8 = c & 15; const int srow = (r < 32) ? (32 * q + r) : (128 + 32 * q + (r - 32));
            *(LAS u32x4*)(WL + r * 136 + c8 * 8) = *(const u32x4*)(wsrc + (size_t)srow * 128 + c8 * 8); }
        if (tid < 64) HC[tid] = 0.f;
        if (tid < 32) { PAR[tid] = p.in[14][gq0 + tid]; PAR[32 + tid] = p.in[16][gq0 + tid]; PAR[64 + tid] = -8.f * softplusf(-p.in[17][gq0 + tid]); } }
    const int ntile = PROMPT ? 16 : 1;
    const int crow = tid >> 2, cpart = tid & 3;
    const int cg = tid & 15, r0 = (tid >> 4) * 4;
    const int gc8 = n * 128 + 8 * cg;
    f32x4 wlo[4], whi[4], blo, bhi;
#pragma unroll
    for (int j = 0; j < 4; ++j) { wlo[j] = *(const f32x4*)(p.in[11] + j * 1024 + gc8); whi[j] = *(const f32x4*)(p.in[11] + j * 1024 + gc8 + 4); }
    blo = *(const f32x4*)(p.in[12] + gc8); bhi = *(const f32x4*)(p.in[12] + gc8 + 4);
    u32x4 xr[7], rgv;
#define RG_LOAD(TT) do { const size_t gr_ = PROMPT ? (size_t)bb0 * 2048 + (TT) * 128 + crow : (size_t)8192 + bb0 * 128 + crow; \
        rgv = *(const u32x4*)(PROJ + gr_ * NPROJ + C_RG + gq0 + 8 * cpart); \
        _Pragma("unroll") for (int k = 0; k < 7; ++k) { const int t_ = PROMPT ? (TT) * 128 + r0 - 3 + k : (r0 & 7) - 3 + k; const int tc_ = t_ > 0 ? t_ : 0; \
            const size_t sr_ = PROMPT ? (size_t)bb0 * 2048 + tc_ : (size_t)8192 + (bb0 * 16 + (r0 >> 3)) * 8 + tc_; \
            xr[k] = *(const u32x4*)(PROJ + sr_ * NPROJ + C_RX + gc8); } } while (0)
    RG_LOAD(0);
    for (int tt = 0; tt < ntile; ++tt) {
        const size_t grow_c = PROMPT ? (size_t)bb0 * 2048 + tt * 128 + crow : (size_t)8192 + bb0 * 128 + crow;
        {
#pragma unroll
            for (int rr = 0; rr < 4; ++rr) { f32x4 alo = blo, ahi = bhi;
#pragma unroll
                for (int j = 0; j < 4; ++j) { const int t = PROMPT ? tt * 128 + r0 + rr - 3 + j : (r0 & 7) + rr - 3 + j;
                    if (t >= 0) { const u32x4 x = xr[rr + j];
                        alo[0] += wlo[j][0] * bf_lo(x.x); alo[1] += wlo[j][1] * bf_hi(x.x); alo[2] += wlo[j][2] * bf_lo(x.y); alo[3] += wlo[j][3] * bf_hi(x.y);
                        ahi[0] += whi[j][0] * bf_lo(x.z); ahi[1] += whi[j][1] * bf_hi(x.z); ahi[2] += whi[j][2] * bf_lo(x.w); ahi[3] += whi[j][3] * bf_hi(x.w);
                    } else if (!PROMPT) { const float* srcf = p.in[5] + (size_t)((bb0 * 16 + (r0 >> 3)) * 3 + 3 + t) * 1024 + gc8;
                        const f32x4 x0 = *(const f32x4*)srcf, x1 = *(const f32x4*)(srcf + 4); alo += wlo[j] * x0; ahi += whi[j] * x1; }
                }
                u32x4 w; w.x = cvt_pk_bf16(alo[0], alo[1]); w.y = cvt_pk_bf16(alo[2], alo[3]); w.z = cvt_pk_bf16(ahi[0], ahi[1]); w.w = cvt_pk_bf16(ahi[2], ahi[3]);
                *(LAS u32x4*)(XA + (r0 + rr) * 136 + 8 * cg) = w; }
            *(LAS u32x4*)(RG + crow * 40 + 8 * cpart) = rgv;
            if (tt + 1 < ntile) RG_LOAD(tt + 1);
        }
        LDS_BAR();
        f32x4 acc[4];
        {   bf16x8 a[4];
#pragma unroll
            for (int k = 0; k < 4; ++k) a[k] = *(const LAS bf16x8*)(XA + (16 * wid + fr) * 136 + 32 * k + fq * 8);
            bf16x8 wf[4][4];
#pragma unroll
            for (int nt = 0; nt < 4; ++nt)
#pragma unroll
                for (int k = 0; k < 4; ++k) wf[nt][k] = *(const LAS bf16x8*)(WL + (16 * nt + fr) * 136 + 32 * k + fq * 8);
#pragma unroll
            for (int nt = 0; nt < 4; ++nt) { f32x4 c = (f32x4){0.f, 0.f, 0.f, 0.f};
#pragma unroll
                for (int k = 0; k < 4; ++k) c = MFMA16(a[k], wf[nt][k], c);
                acc[nt] = c; } }
        float eA[2], eU[2]; float xcv[2][4], pbx[2], pba[2], pc8[2];
#pragma unroll
        for (int nt = 0; nt < 2; ++nt) { const int ch = 16 * nt + fr; pbx[nt] = PAR[ch]; pba[nt] = PAR[32 + ch]; pc8[nt] = PAR[64 + ch];
#pragma unroll
            for (int r = 0; r < 4; ++r) xcv[nt][r] = bf2f(XA[(16 * wid + 4 * fq + r) * 136 + 32 * q + ch]); }
#pragma unroll
        for (int nt = 0; nt < 2; ++nt) { const int ch = 16 * nt + fr;
            const float bx = pbx[nt], ba = pba[nt], c8 = pc8[nt];
#pragma unroll
            for (int r = 0; r < 4; ++r) { const float gi = sigm(acc[nt][r] + bx), gr = sigm(acc[nt + 2][r] + ba); const float la = c8 * gr;
                const float av = __expf(la), mult = sqrtf(fmaxf(1.f - av * av, 0.f)); const float xc = xcv[nt][r];
                acc[nt][r] = mult * gi * xc; acc[nt + 2][r] = av; }
            float A = acc[nt + 2][0], U = acc[nt][0];
#pragma unroll
            for (int r = 1; r < 4; ++r) { U = acc[nt + 2][r] * U + acc[nt][r]; A *= acc[nt + 2][r]; }
            if (PROMPT) {
                float A1 = __shfl_up(A, 16), U1 = __shfl_up(U, 16); if (fq >= 1) { U = A * U1 + U; A = A * A1; }
                A1 = __shfl_up(A, 32); U1 = __shfl_up(U, 32); if (fq >= 2) { U = A * U1 + U; A = A * A1; }
                float Ae = __shfl_up(A, 16), Ue = __shfl_up(U, 16); if (fq == 0) { Ae = 1.f; Ue = 0.f; }
                eA[nt] = Ae; eU[nt] = Ue;
                if (fq == 3) { WT[(wid * 32 + ch) * 2] = A; WT[(wid * 32 + ch) * 2 + 1] = U; }
            } else {
                float Ae = __shfl_up(A, 16), Ue = __shfl_up(U, 16); if ((fq & 1) == 0) { Ae = 1.f; Ue = 0.f; }
                eA[nt] = Ae; eU[nt] = Ue;
            }
        }
        LDS_BAR();
#pragma unroll
        for (int nt = 0; nt < 2; ++nt) { const int ch = 16 * nt + fr, gch = gq0 + ch;
            float hv;
            if (PROMPT) { hv = HC[(tt & 1) * 32 + ch];
                for (int w2 = 0; w2 < wid; ++w2) hv = WT[(w2 * 32 + ch) * 2] * hv + WT[(w2 * 32 + ch) * 2 + 1];
            } else hv = p.in[6][(size_t)(bb0 * 16 + wid * 2 + (fq >> 1)) * 1024 + gch];
            hv = eA[nt] * hv + eU[nt];
#pragma unroll
            for (int r = 0; r < 4; ++r) { hv = acc[nt + 2][r] * hv + acc[nt][r];
                LAS bf16_t* e = RG + (16 * wid + 4 * fq + r) * 40 + ch; *e = f2bf(hv * bf2f(*e)); }
            if (PROMPT) { if (wid == 7 && fq == 3) { HC[((tt & 1) ^ 1) * 32 + ch] = hv; if (tt == 15) p.out[O_RHP + (size_t)bb0 * 1024 + gch] = hv; } }
            else { if (fq & 1) p.out[O_RHS + (size_t)(bb0 * 16 + wid * 2 + (fq >> 1)) * 1024 + gch] = hv; }
        }
        LDS_BAR();
        *(u32x4*)(YR + grow_c * 1024 + gq0 + 8 * cpart) = *(const LAS u32x4*)(RG + crow * 40 + 8 * cpart);
    }
#undef RG_LOAD
}

__device__ __forceinline__ void gdn_sample_pass(LAS unsigned char* lds, const P& p, int pass) {
    const int tid = threadIdx.x, lane = tid & 63, sub = tid >> 8, idx = tid & 255, v = idx >> 1, kh = idx & 1, wv = (tid >> 6) & 3;
    const int item = pass * 2 + sub, b = item >> 3, h = item & 7;
    const bf16_t* PROJ = (const bf16_t*)(p.ws + WS_PROJ); const float* GBA = (const float*)(p.ws + WS_GBA);
    bf16_t* YG = (bf16_t*)(p.ws + WS_YCAT) + (size_t)9216 * 1024;
    LAS float* qv = (LAS float*)(lds + sub * 16896);
    LAS float* kv = qv + 1024;
    LAS float* vv = kv + 1024;
    LAS float* ov = vv + 1024;
    LAS float* red = ov + 1024;
    LAS float* db = red + 96;
    __syncthreads();
    {
        float yq[8], yk[8];
#pragma unroll
        for (int mat = 0; mat < 3; ++mat) { const int ch = mat * 1024 + h * 128 + v; float x[11];
#pragma unroll
            for (int j = 0; j < 3; ++j) x[j] = p.in[7][(size_t)(b * 3 + j) * 3072 + ch];
#pragma unroll
            for (int t = 0; t < 8; ++t) x[3 + t] = bf2f(PROJ[(size_t)(8192 + b * 8 + t) * NPROJ + C_GQ + ch]);
            const float w0 = p.in[18][ch], w1 = p.in[18][3072 + ch], w2 = p.in[18][6144 + ch], w3 = p.in[18][9216 + ch];
#pragma unroll
            for (int t = 0; t < 8; ++t) { const float y = siluf(w0 * x[t] + w1 * x[t + 1] + w2 * x[t + 2] + w3 * x[t + 3]); if (mat == 0) yq[t] = y; else if (mat == 1) yk[t] = y; else if (kh == 0) vv[t * 128 + v] = y; } }
#pragma unroll
        for (int t = 0; t < 8; ++t) { float sq = kh ? 0.f : yq[t] * yq[t], sk = kh ? 0.f : yk[t] * yk[t];
#pragma unroll
            for (int o = 32; o >= 1; o >>= 1) { sq += __shfl_xor(sq, o); sk += __shfl_xor(sk, o); }
            if (lane == 0) { red[wv * 8 + t] = sq; red[32 + wv * 8 + t] = sk; } }
        if (idx < 8) { const float* gr = GBA + (size_t)(8192 + b * 8 + idx) * 16; db[8 + idx] = sigm(gr[h]); db[idx] = __expf(-__expf(p.in[19][h]) * softplusf(gr[8 + h] + p.in[20][h])); }
        __syncthreads();
        if (kh == 0) {
#pragma unroll
            for (int t = 0; t < 8; ++t) { const float rq = rsqrtf(red[t] + red[8 + t] + red[16 + t] + red[24 + t] + 1e-6f) * 0.08838834764831845f, rk = rsqrtf(red[32 + t] + red[40 + t] + red[48 + t] + red[56 + t] + 1e-6f);
                qv[t * 128 + v] = yq[t] * rq; kv[t * 128 + v] = yk[t] * rk; } }
    }
    float Sc[64];
    { const float* s0 = p.in[8] + (size_t)item * 16384 + (size_t)kh * 64 * 128 + v;
#pragma unroll
        for (int k = 0; k < 64; ++k) Sc[k] = s0[k * 128]; }
    __syncthreads();
#pragma unroll 1
    for (int t = 0; t < 8; ++t) {
        const float dect = db[t], betat = db[8 + t], vt = vv[t * 128 + v];
        const LAS float* kt = kv + t * 128 + kh * 64; const LAS float* qt = qv + t * 128 + kh * 64;
        f32x4 kreg[16];
#pragma unroll
        for (int k = 0; k < 16; ++k) kreg[k] = *(const LAS f32x4*)(kt + 4 * k);
        float d0 = 0.f, d1 = 0.f, d2 = 0.f, d3 = 0.f;
#pragma unroll
        for (int k = 0; k < 64; k += 4) { const f32x4 kk = kreg[k >> 2]; d0 += Sc[k] * kk[0]; d1 += Sc[k + 1] * kk[1]; d2 += Sc[k + 2] * kk[2]; d3 += Sc[k + 3] * kk[3]; }
        float dot = (d0 + d1) + (d2 + d3); dot += __shfl_xor(dot, 1);
        const float rr = betat * (vt - dect * dot);
        float o0 = 0.f, o1 = 0.f, o2 = 0.f, o3 = 0.f;
#pragma unroll
        for (int hh = 0; hh < 2; ++hh) { f32x4 qreg[8];
#pragma unroll
            for (int k = 0; k < 8; ++k) qreg[k] = *(const LAS f32x4*)(qt + 32 * hh + 4 * k);
#pragma unroll
            for (int k8 = 0; k8 < 8; ++k8) { const int k = 32 * hh + 4 * k8; const f32x4 kk = kreg[k >> 2], qq = qreg[k8];
                Sc[k] = dect * Sc[k] + kk[0] * rr; Sc[k + 1] = dect * Sc[k + 1] + kk[1] * rr; Sc[k + 2] = dect * Sc[k + 2] + kk[2] * rr; Sc[k + 3] = dect * Sc[k + 3] + kk[3] * rr;
                o0 += Sc[k] * qq[0]; o1 += Sc[k + 1] * qq[1]; o2 += Sc[k + 2] * qq[2]; o3 += Sc[k + 3] * qq[3]; } }
        float ot = (o0 + o1) + (o2 + o3); ot += __shfl_xor(ot, 1);
        if (kh == 0) ov[t * 128 + v] = ot;
    }
    { float* so = p.out + O_GSS + (size_t)item * 16384 + (size_t)kh * 64 * 128 + v;
#pragma unroll
        for (int k = 0; k < 64; ++k) so[k * 128] = Sc[k]; }
    __syncthreads();
#pragma unroll
    for (int t = 0; t < 8; ++t) { const float ot = ov[t * 128 + v]; float s = kh ? 0.f : ot * ot;
#pragma unroll
        for (int oo = 32; oo >= 1; oo >>= 1) s += __shfl_xor(s, oo);
        if (lane == 0) red[64 + wv * 8 + t] = s; }
    __syncthreads();
    if (kh == 0) {
        const float gn = p.in[21][v];
#pragma unroll
        for (int t = 0; t < 8; ++t) { const float rs = rsqrtf((red[64 + t] + red[72 + t] + red[80 + t] + red[88 + t]) * (1.f / 128.f) + 1e-6f); const size_t grow = (size_t)8192 + b * 8 + t;
            const float z = bf2f(PROJ[grow * NPROJ + C_GZ + h * 128 + v]);
            YG[grow * 1024 + h * 128 + v] = f2bf(ov[t * 128 + v] * rs * gn * z); } }
}

template <bool F32SRC>
__device__ __forceinline__ void attn_stage(LAS unsigned char* lds, const void* src, int half) {
    const int tid = threadIdx.x;
    if (F32SRC) { const float* s = (const float*)src + (size_t)half * 128 * 1024; f32x4 a[8], b[8];
#pragma unroll
        for (int i = 0; i < 8; ++i) { const int q = tid + NTHR * i; const float* g = s + (size_t)(q >> 5) * 1024 + (q & 31) * 8; a[i] = *(const f32x4*)g; b[i] = *(const f32x4*)(g + 4); }
#pragma unroll
        for (int i = 0; i < 8; ++i) { const int q = tid + NTHR * i; u32x4 w; w.x = cvt_pk_bf16(a[i][0], a[i][1]); w.y = cvt_pk_bf16(a[i][2], a[i][3]); w.z = cvt_pk_bf16(b[i][0], b[i][1]); w.w = cvt_pk_bf16(b[i][2], b[i][3]);
            *(LAS u32x4*)(lds + (q >> 5) * 528 + (q & 31) * 16) = w; }
    } else { const bf16_t* s = (const bf16_t*)src + (size_t)half * 128 * 1024; u32x4 a[8];
#pragma unroll
        for (int i = 0; i < 8; ++i) { const int q = tid + NTHR * i; a[i] = *(const u32x4*)(s + (size_t)(q >> 5) * 1024 + (q & 31) * 8); }
#pragma unroll
        for (int i = 0; i < 8; ++i) { const int q = tid + NTHR * i; *(LAS u32x4*)(lds + (q >> 5) * 528 + (q & 31) * 16) = a[i]; }
    }
}
template <bool F32SRC>
__device__ __forceinline__ void attn_item(LAS unsigned char* lds, const bf16_t* Q, int nrows, const void* Kb, const void* Vb, bf16_t* O) {
    const int tid = threadIdx.x, lane = tid & 63, wid = __builtin_amdgcn_readfirstlane(tid >> 6), fr = lane & 15, fq = lane >> 4;
    const bool active = (16 * wid < nrows);
    LAS unsigned char* PSw = lds + 69632 + wid * 8448;
    __syncthreads();
    bf16x8 qf[8];
    { const int row = min(16 * wid + fr, nrows - 1);
#pragma unroll
        for (int k = 0; k < 8; ++k) qf[k] = *(const bf16x8*)(Q + (size_t)row * NPROJ + 32 * k + fq * 8); }
    f32x4 sacc[16];
#pragma unroll
    for (int i = 0; i < 16; ++i) sacc[i] = (f32x4){0.f, 0.f, 0.f, 0.f};
#pragma unroll
    for (int half = 0; half < 2; ++half) {
        attn_stage<F32SRC>(lds, Kb, half);
        __syncthreads();
        if (active) {
#pragma unroll
            for (int mt = 0; mt < 8; mt += 2) { bf16x8 kf[2][8];
#pragma unroll
                for (int e = 0; e < 2; ++e)
#pragma unroll
                    for (int k = 0; k < 8; ++k) kf[e][k] = *(const LAS bf16x8*)(lds + (16 * (mt + e) + fr) * 528 + (32 * k + fq * 8) * 2);
#pragma unroll
                for (int e = 0; e < 2; ++e)
#pragma unroll
                    for (int k = 0; k < 8; ++k) sacc[half * 8 + mt + e] = MFMA16(kf[e][k], qf[k], sacc[half * 8 + mt + e]); }
        }
        __syncthreads();
    }
    if (active) {
        float mx = -3.0e38f;
#pragma unroll
        for (int mt = 0; mt < 16; ++mt)
#pragma unroll
            for (int r = 0; r < 4; ++r) mx = fmaxf(mx, sacc[mt][r]);
        mx = fmaxf(mx, __shfl_xor(mx, 16)); mx = fmaxf(mx, __shfl_xor(mx, 32));
        float sum = 0.f;
#pragma unroll
        for (int mt = 0; mt < 16; ++mt)
#pragma unroll
            for (int r = 0; r < 4; ++r) { const float e = __expf((sacc[mt][r] - mx) * 0.0625f); sacc[mt][r] = e; sum += e; }
        sum += __shfl_xor(sum, 16); sum += __shfl_xor(sum, 32);
        const float inv = 1.f / sum;
#pragma unroll
        for (int mt = 0; mt < 16; ++mt) { u32x2 w; w.x = cvt_pk_bf16(sacc[mt][0] * inv, sacc[mt][1] * inv); w.y = cvt_pk_bf16(sacc[mt][2] * inv, sacc[mt][3] * inv);
            *(LAS u32x2*)(PSw + fr * 528 + (16 * mt + 4 * fq) * 2) = w; }
    }
    f32x4 oacc[16];
#pragma unroll
    for (int i = 0; i < 16; ++i) oacc[i] = (f32x4){0.f, 0.f, 0.f, 0.f};
#pragma unroll
    for (int half = 0; half < 2; ++half) {
        attn_stage<F32SRC>(lds, Vb, half);
        __syncthreads();
        if (active) {
#pragma unroll
            for (int k = 0; k < 4; ++k) { const bf16x8 pfrag = *(const LAS bf16x8*)(PSw + fr * 528 + (128 * half + 32 * k + fq * 8) * 2);
#pragma unroll
                for (int d0 = 0; d0 < 16; d0 += 8) { s16x4 lo[8], hi[8];
#pragma unroll
                    for (int e = 0; e < 8; ++e) { LAS unsigned char* va = lds + (32 * k + 8 * fq + (fr >> 2)) * 528 + (16 * (d0 + e) + 4 * (fr & 3)) * 2;
                        lo[e] = __builtin_amdgcn_ds_read_tr16_b64_v4i16((LAS s16x4*)va); hi[e] = __builtin_amdgcn_ds_read_tr16_b64_v4i16((LAS s16x4*)(va + 4 * 528)); }
#pragma unroll
                    for (int e = 0; e < 8; ++e) { bf16x8 vf; vf[0] = lo[e][0]; vf[1] = lo[e][1]; vf[2] = lo[e][2]; vf[3] = lo[e][3]; vf[4] = hi[e][0]; vf[5] = hi[e][1]; vf[6] = hi[e][2]; vf[7] = hi[e][3];
                        oacc[d0 + e] = MFMA16(vf, pfrag, oacc[d0 + e]); } } }
        }
        __syncthreads();
    }
    if (active && 16 * wid + fr < nrows) {
        bf16_t* op = O + (size_t)(16 * wid + fr) * 1024 + 4 * fq;
#pragma unroll
        for (int dt = 0; dt < 16; ++dt) { u32x2 w; w.x = cvt_pk_bf16(oacc[dt][0], oacc[dt][1]); w.y = cvt_pk_bf16(oacc[dt][2], oacc[dt][3]); *(u32x2*)(op + 16 * dt) = w; }
    }
}

__device__ __forceinline__ void conv_states(const P& p, int bid, int G) {
    const bf16_t* PROJ = (const bf16_t*)(p.ws + WS_PROJ);
    const int total = 12288 + 36864 + 393216 + 1179648;
    for (int i = bid * NTHR + threadIdx.x; i < total; i += G * NTHR) {
        int e = i; size_t oo; int bj, ch, col0, W; size_t rowbase; int T;
        if (e < 12288) { oo = O_RCP; W = 1024; col0 = C_RX; T = 2048; rowbase = 0; }
        else if ((e -= 12288) < 36864) { oo = O_GCP; W = 3072; col0 = C_GQ; T = 2048; rowbase = 0; }
        else if ((e -= 36864) < 393216) { oo = O_RCS; W = 1024; col0 = C_RX; T = 8; rowbase = 8192; }
        else { e -= 393216; oo = O_GCS; W = 3072; col0 = C_GQ; T = 8; rowbase = 8192; }
        bj = e / W; ch = e - bj * W; const int b = bj / 3, j = bj - b * 3;
        p.out[oo + e] = bf2f(PROJ[(rowbase + (size_t)b * T + (T - 3 + j)) * NPROJ + col0 + ch]);
    }
}


#ifndef DBG_CHECK
#define DBG_CHECK 1
#endif
__device__ __forceinline__ float blk_sum(LAS float* red, float v) {
    __syncthreads();
#pragma unroll
    for (int o = 32; o >= 1; o >>= 1) v += __shfl_xor(v, o);
    if ((threadIdx.x & 63) == 0) red[threadIdx.x >> 6] = v;
    __syncthreads();
    float t = 0.f;
#pragma unroll
    for (int i = 0; i < 8; ++i) t += red[i];
    return t;
}
__device__ __forceinline__ void dbg_flag(const P& p, unsigned id) { atomicMax((unsigned*)p.ws, id); }
__global__ void __launch_bounds__(NTHR) dbg_check_gemm1(P p) {
    __shared__ float red_s[8]; LAS float* red = (LAS float*)red_s; const int tid = threadIdx.x, bid = blockIdx.x;
    for (int s = bid; s < 1024; s += gridDim.x) {
        const int row = (s * 37 + 11) % 9216; const int oc = (int)(((long)s * 5303 + 7) % 13328);
        const int pc = oc < 6144 ? oc : (oc < 6160 ? 13312 + (oc - 6144) : oc - 16);
        const float* x = row < 8192 ? p.in[0] + (size_t)row * 2048 : p.in[1] + (size_t)(row - 8192) * 2048;
        float ss = 0.f, dot = 0.f;
        for (int k = tid; k < 2048; k += NTHR) { const float xv = x[k]; ss += xv * xv; dot += xv * p.in[9][k] * p.in[10][(size_t)k * 13328 + oc]; }
        ss = blk_sum(red, ss); dot = blk_sum(red, dot);
        float ref = dot * rsqrtf(ss * (1.f / 2048.f) + 1e-6f);
        const int pn = pc >> 8; const int act = (pn >= 4 && pn < 8) ? 1 : (pn >= 20 && pn < 24) ? 2 : (pn >= 28 && pn < 52) ? 3 : 0;
        float got;
        if (pc >= 13312) got = ((const float*)(p.ws + WS_GBA))[(size_t)row * 16 + (pc - 13312)];
        else { got = bf2f(((const bf16_t*)(p.ws + WS_PROJ))[(size_t)row * NPROJ + pc]); if (act) ref = actf(ref, act); }
        if (tid == 0 && !(fabsf(got - ref) <= 0.03f + 0.03f * fabsf(ref))) dbg_flag(p, 1u + (unsigned)(pn >= 52 ? 5 : pn >= 28 ? 4 : pn >= 24 ? 3 : pn >= 8 ? 2 : pn >= 4 ? 1 : 0));
    }
    for (int s = bid; s < 256; s += gridDim.x) {
        const int row = (s * 29 + 3) % 1024; const int oc = (s * 523 + 5) % 2048;
        const float* x = p.in[2] + (size_t)row * 2048;
        float ss = 0.f, dot = 0.f;
        for (int k = tid; k < 2048; k += NTHR) { const float xv = x[k]; ss += xv * xv; dot += xv * p.in[22][k] * p.in[23][(size_t)k * 2048 + oc]; }
        ss = blk_sum(red, ss); dot = blk_sum(red, dot);
        const float ref = dot * rsqrtf(ss * (1.f / 2048.f) + 1e-6f);
        const float got = oc < 1024 ? p.out[O_MK + (size_t)row * 1024 + oc] : p.out[O_MV + (size_t)row * 1024 + oc - 1024];
        if (tid == 0 && !(fabsf(got - ref) <= 0.03f + 0.03f * fabsf(ref))) dbg_flag(p, 10u);
    }
}

__global__ void dbg_scan_bf16(P p, size_t off, size_t n, float bound, unsigned id) {
    const bf16_t* q = (const bf16_t*)(p.ws + off); bool bad = false;
    for (size_t i = (size_t)blockIdx.x * blockDim.x + threadIdx.x; i < n; i += (size_t)gridDim.x * blockDim.x) { const float v = bf2f(q[i]); if (!(fabsf(v) <= bound)) bad = true; }
    if (bad) atomicMax((unsigned*)p.ws, id);
}
__global__ void dbg_scan_f32(P p, const float* q, size_t n, float lo, float hi, unsigned id) {
    bool bad = false;
    for (size_t i = (size_t)blockIdx.x * blockDim.x + threadIdx.x; i < n; i += (size_t)gridDim.x * blockDim.x) { const float v = q[i]; if (!(v >= lo && v <= hi)) bad = true; }
    if (bad) atomicMax((unsigned*)p.ws, id);
}
__global__ void dbg_scan_gp(P p, int suboff, int sublen, float bound, unsigned id) {
    bool bad = false;
    for (int item = blockIdx.x; item < 1024; item += gridDim.x) { const bf16_t* q = (const bf16_t*)(p.ws + WS_GP) + (size_t)item * 36864 + suboff;
        for (int i = threadIdx.x; i < sublen; i += blockDim.x) { const float v = bf2f(q[i]); if (!(fabsf(v) <= bound)) bad = true; } }
    if (bad) atomicMax((unsigned*)p.ws, id);
}
__global__ void dbg_scan2(P p, size_t base, size_t stride, int sublen, float bound, unsigned id_nan, unsigned id_big) {
    bool nan = false, big = false;
    for (int item = blockIdx.x; item < 1024; item += gridDim.x) { const bf16_t* q = (const bf16_t*)(p.ws + base) + (size_t)item * stride;
        for (int i = threadIdx.x; i < sublen; i += blockDim.x) { const float v = bf2f(q[i]); if (v != v) nan = true; else if (fabsf(v) > bound) big = true; } }
    if (nan) atomicMax((unsigned*)p.ws, id_nan); if (big) atomicMax((unsigned*)p.ws, id_big);
}
__global__ void dbg_scanbit(P p, size_t base, size_t stride, int sublen, float bound, unsigned bit) {
    bool bad = false;
    for (int item = blockIdx.x; item < 1024; item += gridDim.x) { const bf16_t* q = (const bf16_t*)(p.ws + base) + (size_t)item * stride;
        for (int i = threadIdx.x; i < sublen; i += blockDim.x) { const float v = bf2f(q[i]); if (!(fabsf(v) <= bound)) bad = true; } }
    if (bad) atomicOr((unsigned*)p.ws + 1, 1u << bit);
}
__global__ void dbg_report(P p) { const unsigned f = *(const unsigned*)p.ws, m = ((const unsigned*)p.ws)[1]; if (m) p.out[O_Y] = 1000.f * (float)(10u + m); else if (f) p.out[O_Y] = 1000.f * (float)f; }

__global__ void __launch_bounds__(NTHR, 2) mega(P p) {
    extern __shared__ __attribute__((aligned(16))) unsigned char lds_raw[];
    LAS unsigned char* lds = (LAS unsigned char*)lds_raw;
    cg::grid_group grid = cg::this_grid();
    const int G = gridDim.x, bid = blockIdx.x, tid = threadIdx.x;
    unsigned char* ws = p.ws;
#define PH(k) (p.ph_lo <= (k) && (k) < p.ph_hi)
#define SEAM(k) do { if (PH(k) && PH((k) + 1)) grid.sync(); } while (0)

    if (PH(0)) phase0(lds, p, bid, G);
    SEAM(0);

    if (PH(1)) {
        { pg8::Gemm g{(const bf16_t*)(ws + WS_XN), (const bf16_t*)(ws + WS_WIN), 9216, NPROJ, 2048, 0}; pg8::StaticOrder S; S.init(9216, NPROJ, G, bid);
          pg8::EpiProj E{(bf16_t*)(ws + WS_PROJ), (float*)(ws + WS_GBA)}; if (EN_GEMM) pg8::gemm_phase(lds, g, S, E); }
        { pg8::Gemm g{(const bf16_t*)(ws + WS_MEMN), (const bf16_t*)(ws + WS_WMKV), 1024, 2048, 2048, 0}; pg8::StaticOrder S; S.init(1024, 2048, G, G - 1 - bid);
          pg8::EpiMemKV E{p.out + O_MK, p.out + O_MV, (bf16_t*)(ws + WS_MKB), (bf16_t*)(ws + WS_MVB)}; if (EN_GEMM) pg8::gemm_phase(lds, g, S, E); }
    }
    SEAM(1);

    if (PH(2)) {
        for (int it = bid; it < 1024 + 512; it += G) {
            if (it < 1024) { if (EN_PREP) gdn_prep_item(lds, p, it); }
            else { const int k = it - 1024, b = k >> 2, h = k & 3;
                if (EN_ATTS) attn_item<true>(lds, (const bf16_t*)(ws + WS_PROJ) + (size_t)(8192 + b * 8) * NPROJ + C_MQ + h * 256, 8,
                                p.in[3] + (size_t)b * 262144 + h * 256, p.in[4] + (size_t)b * 262144 + h * 256,
                                (bf16_t*)(ws + WS_YCAT) + (size_t)2 * 9216 * 1024 + (size_t)(8192 + b * 8) * 1024 + h * 256); }
        }
        conv_states(p, bid, G);
    }
    SEAM(2);

    if (PH(3)) {
        const int NMISC = 256 + 512 + 256;
        if (bid < 32) { if (EN_SEQ && (p.roles & 1)) gdn_seq_item(lds, p, bid); } else if (bid < 160) { if (EN_RGP && (p.roles & 2)) rglru_item<true>(lds, p, bid - 32); }
        if (p.roles & 4) {
            LAS int* slot = (LAS int*)(lds + 137216);
            for (;;) {
                __syncthreads();
                if (tid == 0) *slot = (int)atomicAdd((unsigned*)ws + 16, 1u);
                __syncthreads();
                const int it = *slot;
                if (it >= NMISC) break;
                if (it < 256) { const int b = it >> 6, h = (it >> 4) & 3, t = it & 15; const size_t row0 = (size_t)b * 2048 + t * 128;
                    if (EN_ATTP) attn_item<false>(lds, (const bf16_t*)(ws + WS_PROJ) + row0 * NPROJ + C_MQ + h * 256, 128,
                                     (const bf16_t*)(ws + WS_MKB) + (size_t)b * 262144 + h * 256, (const bf16_t*)(ws + WS_MVB) + (size_t)b * 262144 + h * 256,
                                     (bf16_t*)(ws + WS_YCAT) + (size_t)2 * 9216 * 1024 + row0 * 1024 + h * 256); }
                else if (it < 768) { if (EN_GS) gdn_sample_pass(lds, p, it - 256); }
                else { if (EN_RGS) rglru_item<false>(lds, p, it - 768); }
            }
        }
    }
    SEAM(3);

    if (PH(4)) {
        pg8::Gemm g{(const bf16_t*)(ws + WS_YCAT), (const bf16_t*)(ws + WS_WUPS), 3 * 9216, 3 * 2048, 1024, 0}; pg8::TripleOrder S{G, bid};
        pg8::EpiMerge E{(const bf16_t*)(ws + WS_PROJ), (float*)(ws + WS_GP), (bf16_t*)(ws + WS_MERGED)}; if (EN_GEMM) pg8::gemm_phase(lds, g, S, E);
    }
    SEAM(4);

    if (PH(5)) {
        pg8::Gemm g{(const bf16_t*)(ws + WS_MERGED), (const bf16_t*)(ws + WS_WOUT), 9216, 2048, 2048, 0}; pg8::StaticOrder S; S.init(9216, 2048, G, bid);
        pg8::EpiOut E{p.in[0], p.in[1], p.out + O_Y, (bf16_t*)(ws + WS_XN), (float*)(ws + WS_SS1)}; if (EN_GEMM) pg8::gemm_phase(lds, g, S, E);
    }
    SEAM(5);

    if (PH(6)) {
        pg8::Gemm g{(const bf16_t*)(ws + WS_XN), (const bf16_t*)(ws + WS_WUP), 9216, 8192, 2048, 0}; pg8::StaticOrder S; S.init(9216, 8192, G, bid);
        pg8::EpiUp E{(const float*)(ws + WS_SS1), (bf16_t*)(ws + WS_PROJ)}; if (EN_GEMM) pg8::gemm_phase(lds, g, S, E);
    }
    SEAM(6);

    if (PH(7)) {
        { pg8::Gemm g{(const bf16_t*)(ws + WS_PROJ), (const bf16_t*)(ws + WS_WDN), 9216, 2048, 8192, 0}; pg8::DownMain S{G, bid};
          pg8::EpiDown E{p.out + O_Y, (const bf16_t*)(ws + WS_XN)}; if (EN_GEMM) pg8::gemm_phase(lds, g, S, E); }
        { pg8::Gemm g{(const bf16_t*)(ws + WS_PROJ), (const bf16_t*)(ws + WS_WDN), 9216, 2048, 8192, 16}; pg8::DownTail S{G, bid};
          pg8::EpiDownPart E{(bf16_t*)(ws + WS_GP)}; if (EN_GEMM) pg8::gemm_phase(lds, g, S, E); }
    }
    SEAM(7);

    if (PH(8)) {
        const int lane = tid & 63, wid = tid >> 6; const bf16_t* part = (const bf16_t*)(ws + WS_GP);
        for (int row = bid * 8 + wid; row < 9216; row += G * 8) { float* x = p.out + O_Y + (size_t)row * 2048; f32x4 v[8]; float ss = 0.f;
            if (row < 8192) {
#pragma unroll
                for (int i = 0; i < 8; ++i) { const int c = (i * 64 + lane) * 4; v[i] = *(const f32x4*)(x + c); }
            } else { const bf16_t* xb = (const bf16_t*)(ws + WS_XN) + (size_t)row * 2048;
#pragma unroll
                for (int i = 0; i < 8; ++i) { const u32x2 r = *(const u32x2*)(xb + (i * 64 + lane) * 4); v[i] = (f32x4){bf_lo(r.x), bf_hi(r.x), bf_lo(r.y), bf_hi(r.y)}; }
#pragma unroll 1
                for (int sl = 0; sl < 8; ++sl) { const bf16_t* pr = part + ((size_t)sl * 1024 + (row - 8192)) * 2048;
#pragma unroll
                    for (int i = 0; i < 8; ++i) { const u32x2 r = *(const u32x2*)(pr + (i * 64 + lane) * 4); v[i][0] += bf_lo(r.x); v[i][1] += bf_hi(r.x); v[i][2] += bf_lo(r.y); v[i][3] += bf_hi(r.y); } } }
#pragma unroll
            for (int i = 0; i < 8; ++i) ss += v[i][0] * v[i][0] + v[i][1] * v[i][1] + v[i][2] * v[i][2] + v[i][3] * v[i][3];
#pragma unroll
            for (int o = 32; o >= 1; o >>= 1) ss += __shfl_xor(ss, o);
            const float rs = rsqrtf(ss * (1.f / 2048.f) + 1e-6f);
#pragma unroll
            for (int i = 0; i < 8; ++i) { const int c = (i * 64 + lane) * 4; *(f32x4*)(x + c) = v[i] * rs * *(const f32x4*)(p.in[31] + c); } }
    }
#undef PH
#undef SEAM
}

extern "C" void kernel_launch(void* const* d_in, const int* in_sizes, int n_in, void* d_out, int out_size, void* d_ws, size_t ws_size, hipStream_t stream) {
    static int grid = 0;
    if (grid == 0) {
        if (n_in != 32 || out_size != 40030208 || ws_size < WS_END) { fprintf(stderr, "kernel_launch: unexpected shapes (n_in %d, out %d, ws %zu; need ws >= %zu)\n", n_in, out_size, ws_size, (size_t)WS_END); grid = -1; return; }
        int dev = 0, cus = 0, per_cu = 0;
        hipGetDevice(&dev); hipDeviceGetAttribute(&cus, hipDeviceAttributeMultiprocessorCount, dev);
        if (hipFuncSetAttribute((const void*)mega, hipFuncAttributeMaxDynamicSharedMemorySize, LDS_BYTES) != hipSuccess) { fprintf(stderr, "kernel_launch: hipFuncSetAttribute failed\n"); grid = -1; return; }
        if (hipOccupancyMaxActiveBlocksPerMultiprocessor(&per_cu, (const void*)mega, NTHR, LDS_BYTES) != hipSuccess || per_cu < 1) { fprintf(stderr, "kernel_launch: occupancy query says %d\n", per_cu); (void)hipGetLastError(); per_cu = 1; }
        grid = cus * 1;
        if (grid < 192) { fprintf(stderr, "kernel_launch: needs >= 192 CUs (got %d)\n", grid); grid = -1; return; }
    }
    if (grid < 0) return;
    P p{};
    for (int i = 0; i < 32; ++i) p.in[i] = (const float*)d_in[i];
    p.out = (float*)d_out; p.ws = (unsigned char*)d_ws; p.roles = 7;
#if defined(PROBE_SEGS)
    { static const int segs[][2] = PROBE_SEGS; const int nseg = (int)(sizeof(segs) / sizeof(segs[0]));
      for (int si = 0; si < nseg; ++si) { P q = p; q.ph_lo = segs[si][0]; q.ph_hi = segs[si][1]; if (si == 1) q.roles = PROBE_ROLES; void* qa[] = {&q};
          if (q.ph_hi - q.ph_lo > 1) (void)hipLaunchCooperativeKernel((const void*)mega, dim3(grid), dim3(NTHR), qa, LDS_BYTES, stream);
          else hipLaunchKernelGGL(mega, dim3(grid), dim3(NTHR), LDS_BYTES, stream, q); } }
#elif ONE_LAUNCH
    p.ph_lo = 0; p.ph_hi = DBG_PH_HI;
    void* args[] = {&p};
    hipError_t e = hipLaunchCooperativeKernel((const void*)mega, dim3(grid), dim3(NTHR), args, LDS_BYTES, stream);
    if (e != hipSuccess) fprintf(stderr, "cooperative launch failed: %s (grid %d)\n", hipGetErrorString(e), grid);
#else
    (void)hipMemsetAsync(d_ws, 0, 256, stream);
    for (int k = 0; k < DBG_PH_HI; ++k) { p.ph_lo = k; p.ph_hi = k + 1; hipLaunchKernelGGL(mega, dim3(grid), dim3(NTHR), LDS_BYTES, stream, p);
        if (k == 1) hipLaunchKernelGGL(dbg_check_gemm1, dim3(256), dim3(NTHR), 0, stream, p);
        if (k == 2) { hipLaunchKernelGGL(dbg_scan_f32, dim3(4), dim3(256), 0, stream, p, (const float*)((unsigned char*)d_ws + WS_DEC), (size_t)1024, 0.f, 1.f, 21u);
            hipLaunchKernelGGL(dbg_scanbit, dim3(256), dim3(256), 0, stream, p, (size_t)WS_GP, (size_t)36864, 8192, 100.f, 0u);
            hipLaunchKernelGGL(dbg_scanbit, dim3(256), dim3(256), 0, stream, p, (size_t)WS_GP + 16384 * 2, (size_t)36864, 8192, 100.f, 1u); }
    }
    hipLaunchKernelGGL(dbg_report, dim3(1), dim3(1), 0, stream, p);
#endif
}
```

```cpp
#include <hip/hip_runtime.h>
#include <hip/hip_cooperative_groups.h>
#include <cstdio>
namespace cg = cooperative_groups;

#ifndef ONE_LAUNCH
#define ONE_LAUNCH 1
#endif
#ifndef DBG_DUMP
#define DBG_DUMP 0
#endif
#ifndef DBG_SEQ_SUM
#define DBG_SEQ_SUM 0
#endif
#ifndef DBG_PH_HI
#define DBG_PH_HI 9
#endif


#ifndef EN_ALL
#define EN_ALL 1
#endif
#ifndef EN_PREP
#define EN_PREP EN_ALL
#endif
#ifndef EN_ATTS
#define EN_ATTS EN_ALL
#endif
#ifndef EN_SEQ
#define EN_SEQ EN_ALL
#endif
#ifndef EN_RGP
#define EN_RGP EN_ALL
#endif
#ifndef EN_ATTP
#define EN_ATTP EN_ALL
#endif
#ifndef EN_GS
#define EN_GS EN_ALL
#endif
#ifndef EN_RGS
#define EN_RGS EN_ALL
#endif
#ifndef EN_GEMM
#define EN_GEMM EN_ALL
#endif
#define LAS __attribute__((address_space(3)))
typedef unsigned short bf16_t;
typedef short bf16x8 __attribute__((ext_vector_type(8)));
typedef short s16x4 __attribute__((ext_vector_type(4)));
typedef float f32x4 __attribute__((ext_vector_type(4)));
typedef unsigned u32x4 __attribute__((ext_vector_type(4)));
typedef unsigned u32x2 __attribute__((ext_vector_type(2)));

constexpr int NPROJ = 13568;
constexpr int C_RX = 0, C_RG = 1024, C_GQ = 2048, C_GZ = 5120, C_MQ = 6144, C_MG = 7168;
constexpr int NTHR = 512;
constexpr int LDS_BYTES = 137280;
constexpr int NPHASE = 9;

constexpr size_t O_Y = 0, O_MK = 18874368, O_MV = 19922944, O_RCP = 20971520, O_RHP = 20983808, O_GCP = 20987904, O_GSP = 21024768,
                 O_RCS = 21549056, O_RHS = 21942272, O_GCS = 22073344, O_GSS = 23252992;
constexpr size_t WS_SS1 = 4096, WS_SS2 = 40960, WS_DEC = 77824, WS_GBA = 81920, WS_WIN = 1048576, WS_WMKV = 56623104, WS_WUPS = 65011712,
                 WS_WOUT = 77594624, WS_WUP = 85983232, WS_WDN = 119537664, WS_WRG = 153092096, WS_XN = 153616384, WS_MEMN = 191365120,
                 WS_MKB = 195559424, WS_MVB = 197656576, WS_YCAT = 199753728, WS_MERGED = 256376832, WS_GP = 294125568, WS_PROJ = 369623040,
                 WS_END = 619708416;

struct P { const float* in[32]; float* out; unsigned char* ws; int ph_lo, ph_hi, roles, pad; };

typedef __bf16 bf16v2_t __attribute__((ext_vector_type(2)));
typedef float f32v2_t __attribute__((ext_vector_type(2)));
__device__ __forceinline__ unsigned cvt_pk_bf16(float lo, float hi) { const f32v2_t v = {lo, hi}; const bf16v2_t b = __builtin_convertvector(v, bf16v2_t); return __builtin_bit_cast(unsigned, b); }
__device__ __forceinline__ bf16_t f2bf(float f) { return (bf16_t)(cvt_pk_bf16(f, 0.f) & 0xffffu); }
__device__ __forceinline__ float bf2f(bf16_t b) { return __uint_as_float(((unsigned)b) << 16); }
__device__ __forceinline__ float bf_lo(unsigned u) { return __uint_as_float(u << 16); }
__device__ __forceinline__ float bf_hi(unsigned u) { return __uint_as_float(u & 0xffff0000u); }
__device__ __forceinline__ float sigm(float x) { return __builtin_amdgcn_rcpf(1.f + __expf(-x)); }
__device__ __forceinline__ float siluf(float x) { return x * sigm(x); }
__device__ __forceinline__ float softplusf(float x) { return fmaxf(x, 0.f) + log1pf(__expf(-fabsf(x))); }
__device__ __forceinline__ float actf(float x, int act) {
    if (act == 1) { const float t = 1.5957691216f * (x + 0.044715f * x * x * x); return x * sigm(t); }
    if (act == 2) return x * sigm(x);
    return sigm(x);
}
__device__ __forceinline__ float DBGFIN(float x) { return x; }
#define LDS_BAR() do { asm volatile("s_waitcnt lgkmcnt(0)" ::: "memory"); __builtin_amdgcn_s_barrier(); asm volatile("" ::: "memory"); } while (0)
#define MFMA16(a, b, c) __builtin_amdgcn_mfma_f32_16x16x32_bf16((a), (b), (c), 0, 0, 0)

namespace pg8 {
constexpr int BM = 256, BK = 64, HALF = 128, HTB = HALF * BK * 2, STAGE_BYTES = 8 * HTB, NXCD = 8, WGM = 8;
__host__ __device__ __forceinline__ int lds_byte(int r, int c) { const int st = (r >> 4) * 2 + (c >> 5), rr = r & 15, cc = c & 31, ob = rr * 64 + cc * 2; return st * 1024 + (ob ^ (((ob >> 9) & 1) << 5)); }
__host__ __device__ __forceinline__ void stage_rc(int b, int& R, int& C) { const int st = b / 1024, sb = b % 1024, swz = sb ^ (((sb >> 9) & 1) << 5); R = (st >> 1) * 16 + swz / 64; C = (st & 1) * 32 + (swz % 64) / 2; }
__host__ __device__ __forceinline__ int perm32(int rho) { const int n = rho >> 4, i = rho & 15; return 8 * (i >> 2) + 4 * n + (i & 3); }
struct Unit { int pm, pn, k0; };
struct Gemm { const bf16_t* A; const bf16_t* Bt; int M, N, K; int ntu; };
struct StaticOrder {
    int nM, nN, nwg, G, c;
    __device__ void init(int M, int N, int G_, int c_) { nM = M / BM; nN = N / BM; nwg = nM * nN; G = G_; c = c_; }
    __device__ bool next(int i, Unit& u) const {
        const long L = (long)i * G + c; if (L >= nwg) return false;
        int wgid = (int)L; { const int q = nwg / NXCD, r = nwg % NXCD, xcd = wgid % NXCD, off = wgid / NXCD; wgid = (xcd < r ? xcd * (q + 1) : r * (q + 1) + (xcd - r) * q) + off; }
        const int nig = WGM * nN, gid = wgid / nig, fm = gid * WGM, gsz = (nM - fm) < WGM ? (nM - fm) : WGM;
        u.pm = fm + ((wgid % nig) % gsz); u.pn = (wgid % nig) / gsz; u.k0 = 0; return true;
    }
};
struct TripleOrder {
    int G, c;
    __device__ bool next(int i, Unit& u) const {
        const int tile = (i / 3) * G + c; if (tile >= 288) return false;
        const int br = i % 3; u.pm = br * 36 + (tile % 36); u.pn = br * 8 + (tile / 36); u.k0 = 0; return true;
    }
};

struct DownMain { int G, c; __device__ bool next(int i, Unit& u) const { const int L = i * G + c; if (L >= 256) return false; u.pm = L >> 3; u.pn = L & 7; u.k0 = 0; return true; } };
struct DownTail { int G, c; __device__ bool next(int i, Unit& u) const { const int L = i * G + c; if (L >= 256) return false; const int t = L >> 3; u.pm = 32 + (t >> 3); u.pn = t & 7; u.k0 = (L & 7) * 16; return true; } };

template <class Epi, class Sched>
__device__ __forceinline__ void gemm_phase(LAS unsigned char* lds, const Gemm g, const Sched& S, const Epi& E) {
    const int tid = threadIdx.x, wid = __builtin_amdgcn_readfirstlane(tid >> 6), lane = tid & 63, wr = wid >> 2, wc = wid & 3, fr = lane & 15, fq = lane >> 4;
    const int K = g.K, nt = g.ntu ? g.ntu : K / BK;
    unsigned voffA[2], voffB[2];
#pragma unroll
    for (int i = 0; i < 2; ++i) { int R, C; stage_rc(tid * 16 + i * 8192, R, C); const int Rb = Epi::PERM ? ((R & ~31) + perm32(R & 31)) : R;
        voffA[i] = (unsigned)(R * K + C) * 2u; voffB[i] = (unsigned)(Rb * K + C) * 2u; }
    const size_t kstep = (size_t)(BK * 2);
    const size_t hstep = (size_t)HALF * K * 2;
    const size_t tstep = 2 * hstep;
    const unsigned ldsw = (unsigned)wid * 1024u;
    const int aoff = lds_byte(wr * 64 + fr, fq * 8), boff = lds_byte(wc * 32 + fr, fq * 8);
#define PG8_SA(b, h) (((b) * 2 + (h)) * HTB)
#define PG8_SB(b, h) ((4 + (b) * 2 + (h)) * HTB)
#define PG8_STAGE(bufoff, gbase, voff) do { _Pragma("unroll") for (int _i = 0; _i < 2; ++_i) \
        __builtin_amdgcn_global_load_lds((const unsigned*)((const char*)(gbase) + (voff)[_i]), (LAS unsigned*)(lds + (bufoff) + ldsw + _i * 8192), 16, 0, 0); } while (0)
#define PG8_LDA(dst, b, h) do { _Pragma("unroll") for (int m = 0; m < 4; ++m) _Pragma("unroll") for (int k = 0; k < 2; ++k) dst[m][k] = *(const LAS bf16x8*)(lds + PG8_SA(b, h) + aoff + m * 2048 + k * 1024); } while (0)
#define PG8_LDB(dst, b, h) do { _Pragma("unroll") for (int n = 0; n < 2; ++n) _Pragma("unroll") for (int k = 0; k < 2; ++k) dst[n][k] = *(const LAS bf16x8*)(lds + PG8_SB(b, h) + boff + n * 2048 + k * 1024); } while (0)
#define PG8_MMA(ai, bj, At, Bt) do { __builtin_amdgcn_s_setprio(1); _Pragma("unroll") for (int m = 0; m < 4; ++m) _Pragma("unroll") for (int n = 0; n < 2; ++n) _Pragma("unroll") for (int k = 0; k < 2; ++k) \
        acc[ai][bj][m][n] = __builtin_amdgcn_mfma_f32_16x16x32_bf16(Bt[n][k], At[m][k], acc[ai][bj][m][n], 0, 0, 0); __builtin_amdgcn_s_setprio(0); } while (0)
#define PG8_WAIT_V(n) asm volatile("s_waitcnt vmcnt(" #n ")" ::: "memory")
#define PG8_WAIT_L(n) asm volatile("s_waitcnt lgkmcnt(" #n ")" ::: "memory")
#define PG8_BAR __builtin_amdgcn_s_barrier()
#define PG8_SCHED __builtin_amdgcn_sched_barrier(0)
    Unit cur, nxt; int ui = 0;
    if (!S.next(0, cur)) return;
    f32x4 acc[2][2][4][2];
#pragma unroll
    for (int a = 0; a < 2; ++a)
#pragma unroll
        for (int b = 0; b < 2; ++b)
#pragma unroll
            for (int m = 0; m < 4; ++m)
#pragma unroll
                for (int n = 0; n < 2; ++n) acc[a][b][m][n] = (f32x4){0.f, 0.f, 0.f, 0.f};
    bf16x8 At[4][2], B0[2][2], B1[2][2];
    const char* cA = (const char*)g.A + (size_t)cur.pm * tstep + (size_t)cur.k0 * (BK * 2); const char* cB = (const char*)g.Bt + (size_t)cur.pn * tstep + (size_t)cur.k0 * (BK * 2);
    PG8_STAGE(PG8_SB(0, 0), cB, voffB); PG8_STAGE(PG8_SA(0, 0), cA, voffA); PG8_STAGE(PG8_SB(0, 1), cB + hstep, voffB); PG8_STAGE(PG8_SA(0, 1), cA + hstep, voffA);
    if (wr == 1) PG8_BAR;
    PG8_WAIT_V(4); PG8_BAR;
    PG8_STAGE(PG8_SB(1, 0), cB + kstep, voffB); PG8_STAGE(PG8_SA(1, 0), cA + kstep, voffA); PG8_STAGE(PG8_SB(1, 1), cB + hstep + kstep, voffB);
    PG8_WAIT_V(6); PG8_BAR;
    for (;;) {
        const bool has_next = S.next(ui + 1, nxt);
        const char* nA = has_next ? (const char*)g.A + (size_t)nxt.pm * tstep + (size_t)nxt.k0 * (BK * 2) : cA; const char* nB = has_next ? (const char*)g.Bt + (size_t)nxt.pn * tstep + (size_t)nxt.k0 * (BK * 2) : cB;
        for (int t = 0; t < nt; t += 2) {
            const bool last = (t == nt - 2);
            const char* a1 = cA + (size_t)(t + 1) * kstep;
            const char* a2 = last ? nA : cA + (size_t)(t + 2) * kstep; const char* b2 = last ? nB : cB + (size_t)(t + 2) * kstep;
            const char* a3 = a2 + kstep; const char* b3 = b2 + kstep;
            PG8_LDB(B0, 0, 0); PG8_SCHED; PG8_LDA(At, 0, 0); PG8_STAGE(PG8_SA(1, 1), a1 + hstep, voffA);
            PG8_WAIT_L(8); PG8_BAR; PG8_WAIT_L(0); PG8_MMA(0, 0, At, B0); PG8_BAR; PG8_SCHED;
            PG8_LDB(B1, 0, 1); PG8_STAGE(PG8_SB(0, 0), b2, voffB);
            PG8_BAR; PG8_WAIT_L(0); PG8_MMA(0, 1, At, B1); PG8_BAR;
            PG8_LDA(At, 0, 1); PG8_STAGE(PG8_SA(0, 0), a2, voffA);
            PG8_BAR; PG8_WAIT_L(0); PG8_MMA(1, 0, At, B0); PG8_BAR; PG8_SCHED;
            PG8_STAGE(PG8_SB(0, 1), b2 + hstep, voffB);
            PG8_WAIT_V(6); PG8_BAR; PG8_MMA(1, 1, At, B1); PG8_BAR;
            PG8_LDB(B0, 1, 0); PG8_SCHED; PG8_LDA(At, 1, 0); PG8_STAGE(PG8_SA(0, 1), a2 + hstep, voffA);
            PG8_WAIT_L(8); PG8_BAR; PG8_WAIT_L(0); PG8_MMA(0, 0, At, B0); PG8_BAR; PG8_SCHED;
            PG8_LDB(B1, 1, 1); PG8_STAGE(PG8_SB(1, 0), b3, voffB);
            PG8_BAR; PG8_WAIT_L(0); PG8_MMA(0, 1, At, B1); PG8_BAR;
            PG8_LDA(At, 1, 1); PG8_STAGE(PG8_SA(1, 0), a3, voffA);
            PG8_BAR; PG8_WAIT_L(0); PG8_MMA(1, 0, At, B0); PG8_BAR; PG8_SCHED;
            PG8_STAGE(PG8_SB(1, 1), b3 + hstep, voffB);
            PG8_WAIT_V(6); PG8_BAR; PG8_MMA(1, 1, At, B1); PG8_BAR;
        }
        E(acc, cur, wr, wc, fr, fq);
        if (!has_next) break;
#pragma unroll
        for (int a = 0; a < 2; ++a)
#pragma unroll
            for (int b = 0; b < 2; ++b)
#pragma unroll
                for (int m = 0; m < 4; ++m)
#pragma unroll
                    for (int n = 0; n < 2; ++n) acc[a][b][m][n] = (f32x4){0.f, 0.f, 0.f, 0.f};
        cur = nxt; cA = nA; cB = nB; ++ui;
    }
    PG8_WAIT_V(0);
    if (wr == 0) PG8_BAR;
    PG8_BAR;
#undef PG8_SA
#undef PG8_SB
#undef PG8_STAGE
#undef PG8_LDA
#undef PG8_LDB
#undef PG8_MMA
#undef PG8_WAIT_V
#undef PG8_WAIT_L
#undef PG8_BAR
#undef PG8_SCHED
}

typedef f32x4 Acc[2][2][4][2];

struct EpiProj {
    static constexpr bool PERM = true;
    bf16_t* O; float* gba;
    __device__ __forceinline__ void operator()(const Acc& acc, const Unit& u, int wr, int wc, int fr, int fq) const {
        const int row0 = u.pm * BM + wr * 64 + fr, col0 = u.pn * BM + wc * 32 + 8 * fq;
        const int pn = u.pn; const int act = (pn >= 4 && pn < 8) ? 1 : (pn >= 20 && pn < 24) ? 2 : (pn >= 28 && pn < 52) ? 3 : 0;
#pragma unroll
        for (int ai = 0; ai < 2; ++ai)
#pragma unroll
            for (int m = 0; m < 4; ++m) { bf16_t* rowp = O + (size_t)(row0 + ai * HALF + m * 16) * NPROJ + col0;
#pragma unroll
                for (int bj = 0; bj < 2; ++bj) { f32x4 v0 = acc[ai][bj][m][0], v1 = acc[ai][bj][m][1];
                    if (act) {
#pragma unroll
                        for (int j = 0; j < 4; ++j) { v0[j] = actf(v0[j], act); v1[j] = actf(v1[j], act); } }
                    u32x4 w; w.x = cvt_pk_bf16(v0[0], v0[1]); w.y = cvt_pk_bf16(v0[2], v0[3]); w.z = cvt_pk_bf16(v1[0], v1[1]); w.w = cvt_pk_bf16(v1[2], v1[3]);
                    *(u32x4*)(rowp + bj * HALF) = w; } }
        if (pn == 52 && wc == 0 && fq < 2) {
#pragma unroll
            for (int ai = 0; ai < 2; ++ai)
#pragma unroll
                for (int m = 0; m < 4; ++m) { float* gp = gba + (size_t)(row0 + ai * HALF + m * 16) * 16 + 8 * fq;
                    *(f32x4*)gp = acc[ai][0][m][0]; *(f32x4*)(gp + 4) = acc[ai][0][m][1]; } }
    }
};
struct EpiMemKV {
    static constexpr bool PERM = true;
    float* outk; float* outv; bf16_t* kb; bf16_t* vb;
    __device__ __forceinline__ void operator()(const Acc& acc, const Unit& u, int wr, int wc, int fr, int fq) const {
        const int row0 = u.pm * BM + wr * 64 + fr; const bool isv = u.pn >= 4; const int col0 = (u.pn & 3) * BM + wc * 32 + 8 * fq;
        float* of = isv ? outv : outk; bf16_t* ob = isv ? vb : kb;
#pragma unroll
        for (int ai = 0; ai < 2; ++ai)
#pragma unroll
            for (int m = 0; m < 4; ++m) { const size_t ro = (size_t)(row0 + ai * HALF + m * 16) * 1024 + col0;
#pragma unroll
                for (int bj = 0; bj < 2; ++bj) { const f32x4 v0 = acc[ai][bj][m][0], v1 = acc[ai][bj][m][1];
                    *(f32x4*)(of + ro + bj * HALF) = v0; *(f32x4*)(of + ro + bj * HALF + 4) = v1;
                    u32x4 w; w.x = cvt_pk_bf16(v0[0], v0[1]); w.y = cvt_pk_bf16(v0[2], v0[3]); w.z = cvt_pk_bf16(v1[0], v1[1]); w.w = cvt_pk_bf16(v1[2], v1[3]);
                    *(u32x4*)(ob + ro + bj * HALF) = w; } }
    }
};
struct EpiMerge {
    static constexpr bool PERM = true;
    const bf16_t* proj; float* mf; bf16_t* merged;
    __device__ __forceinline__ void operator()(const Acc& acc, const Unit& u, int wr, int wc, int fr, int fq) const {
        const int br = u.pm / 36, pm = u.pm - br * 36, pn = u.pn & 7;
        const int row0 = pm * BM + wr * 64 + fr, col0 = pn * BM + wc * 32 + 8 * fq;
#pragma unroll
        for (int ai = 0; ai < 2; ++ai)
#pragma unroll
            for (int m = 0; m < 4; ++m) { const size_t row = (size_t)(row0 + ai * HALF + m * 16);
#pragma unroll
                for (int bj = 0; bj < 2; ++bj) { const int col = col0 + bj * HALF;
                    const u32x4 gw = *(const u32x4*)(proj + row * NPROJ + C_MG + br * 2048 + col);
                    f32x4 v0 = acc[ai][bj][m][0], v1 = acc[ai][bj][m][1];
                    v0[0] *= bf_lo(gw.x); v0[1] *= bf_hi(gw.x); v0[2] *= bf_lo(gw.y); v0[3] *= bf_hi(gw.y);
                    v1[0] *= bf_lo(gw.z); v1[1] *= bf_hi(gw.z); v1[2] *= bf_lo(gw.w); v1[3] *= bf_hi(gw.w);
                    bf16_t* mp = merged + row * 2048 + col;
                    if (br > 0) { const u32x4 pv = *(const u32x4*)mp; v0[0] += bf_lo(pv.x); v0[1] += bf_hi(pv.x); v0[2] += bf_lo(pv.y); v0[3] += bf_hi(pv.y);
                        v1[0] += bf_lo(pv.z); v1[1] += bf_hi(pv.z); v1[2] += bf_lo(pv.w); v1[3] += bf_hi(pv.w); }
                    { u32x4 w; w.x = cvt_pk_bf16(v0[0], v0[1]); w.y = cvt_pk_bf16(v0[2], v0[3]); w.z = cvt_pk_bf16(v1[0], v1[1]); w.w = cvt_pk_bf16(v1[2], v1[3]);
                        *(u32x4*)mp = w; } }
                asm volatile("" ::: "memory"); }
    }
};
struct EpiOut {
    static constexpr bool PERM = true;
    const float* xp; const float* xs; float* x1; bf16_t* x1b; float* ss;
    __device__ __forceinline__ void operator()(const Acc& acc, const Unit& u, int wr, int wc, int fr, int fq) const {
        const int row0 = u.pm * BM + wr * 64 + fr, col0 = u.pn * BM + wc * 32 + 8 * fq;
        const float* xb = (u.pm < 32) ? xp : xs - (size_t)8192 * 2048;
#pragma unroll
        for (int ai = 0; ai < 2; ++ai)
#pragma unroll
            for (int m = 0; m < 4; ++m) { const size_t row = (size_t)(row0 + ai * HALF + m * 16); float s = 0.f;
#pragma unroll
                for (int bj = 0; bj < 2; ++bj) { const size_t o = row * 2048 + col0 + bj * HALF;
                    const f32x4 v0 = acc[ai][bj][m][0] + *(const f32x4*)(xb + o), v1 = acc[ai][bj][m][1] + *(const f32x4*)(xb + o + 4);
                    s += v0[0] * v0[0] + v0[1] * v0[1] + v0[2] * v0[2] + v0[3] * v0[3] + v1[0] * v1[0] + v1[1] * v1[1] + v1[2] * v1[2] + v1[3] * v1[3];
                    u32x4 w; w.x = cvt_pk_bf16(v0[0], v0[1]); w.y = cvt_pk_bf16(v0[2], v0[3]); w.z = cvt_pk_bf16(v1[0], v1[1]); w.w = cvt_pk_bf16(v1[2], v1[3]);
                    *(u32x4*)(x1b + o) = w; }
                s += __shfl_xor(s, 16); s += __shfl_xor(s, 32);
                if (fq == 0) atomicAdd(ss + row, s); }
    }
};
struct EpiUp {
    static constexpr bool PERM = true;
    const float* ss; bf16_t* hid;
    __device__ __forceinline__ void operator()(const Acc& acc, const Unit& u, int wr, int wc, int fr, int fq) const {
        const int row0 = u.pm * BM + wr * 64 + fr, col0 = u.pn * BM + wc * 32 + 8 * fq;
#pragma unroll
        for (int ai = 0; ai < 2; ++ai)
#pragma unroll
            for (int m = 0; m < 4; ++m) { const size_t row = (size_t)(row0 + ai * HALF + m * 16); const float rs = rsqrtf(ss[row] * (1.f / 2048.f) + 1e-6f);
#pragma unroll
                for (int bj = 0; bj < 2; ++bj) { f32x4 v0 = acc[ai][bj][m][0] * rs, v1 = acc[ai][bj][m][1] * rs;
#pragma unroll
                    for (int j = 0; j < 4; ++j) { const float a = fmaxf(v0[j], 0.f), b = fmaxf(v1[j], 0.f); v0[j] = a * a; v1[j] = b * b; }
                    u32x4 w; w.x = cvt_pk_bf16(v0[0], v0[1]); w.y = cvt_pk_bf16(v0[2], v0[3]); w.z = cvt_pk_bf16(v1[0], v1[1]); w.w = cvt_pk_bf16(v1[2], v1[3]);
                    *(u32x4*)(hid + row * 8192 + col0 + bj * HALF) = w; } }
    }
};
struct EpiDown {
    static constexpr bool PERM = false;
    float* x; const bf16_t* x1b;
    __device__ __forceinline__ void operator()(const Acc& acc, const Unit& u, int wr, int wc, int fr, int fq) const {
        const int row0 = u.pm * BM + wr * 64 + fr, col0 = u.pn * BM + wc * 32 + 4 * fq;
#pragma unroll
        for (int ai = 0; ai < 2; ++ai)
#pragma unroll
            for (int m = 0; m < 4; ++m) { const size_t ro = (size_t)(row0 + ai * HALF + m * 16) * 2048 + col0;
#pragma unroll
                for (int bj = 0; bj < 2; ++bj)
#pragma unroll
                    for (int n = 0; n < 2; ++n) { const size_t o = ro + bj * HALF + n * 16; const u32x2 r = *(const u32x2*)(x1b + o);
                        f32x4 v = acc[ai][bj][m][n]; v[0] += bf_lo(r.x); v[1] += bf_hi(r.x); v[2] += bf_lo(r.y); v[3] += bf_hi(r.y); *(f32x4*)(x + o) = v; } }
    }
};
struct EpiDownPart {
    static constexpr bool PERM = false;
    float* part;
    __device__ __forceinline__ void operator()(const Acc& acc, const Unit& u, int wr, int wc, int fr, int fq) const {
        const int row0 = (u.pm - 32) * BM + wr * 64 + fr, col0 = u.pn * BM + wc * 32 + 4 * fq; float* pb = part + (size_t)(u.k0 >> 4) * 1024 * 2048;
#pragma unroll
        for (int ai = 0; ai < 2; ++ai)
#pragma unroll
            for (int m = 0; m < 4; ++m) { float* rowp = pb + (size_t)(row0 + ai * HALF + m * 16) * 2048 + col0;
#pragma unroll
                for (int bj = 0; bj < 2; ++bj)
#pragma unroll
                    for (int n = 0; n < 2; ++n) *(f32x4*)(rowp + bj * HALF + n * 16) = acc[ai][bj][m][n]; }
    }
};
}

__device__ __forceinline__ int win_map(int nd) { return nd < 6144 ? nd : (nd < 13312 ? nd + 16 : (nd < 13328 ? nd - 13312 + 6144 : -1)); }
__device__ __forceinline__ void tconv_tile(LAS float* T, const float* __restrict__ src, int K, int Nsrc, bf16_t* __restrict__ dst,
                                           const float* __restrict__ kscale, bool winmap, int t) {
    const int lane = threadIdx.x & 63; const int ntk = K / 64;
    const int tk = t % ntk, tn = t / ntk, k0 = tk * 64, n0 = tn * 64;
    f32x4 v[16];
#pragma unroll
    for (int i = 0; i < 16; ++i) { const int q = lane + 64 * i, kr = q >> 4, c4 = q & 15; const int nd = n0 + c4 * 4; const int ns = winmap ? win_map(nd) : nd;
        v[i] = (f32x4){0.f, 0.f, 0.f, 0.f};
        if (ns >= 0) v[i] = *(const f32x4*)(src + (size_t)(k0 + kr) * Nsrc + ns);
        if (kscale) v[i] *= kscale[k0 + kr]; }
#pragma unroll
    for (int i = 0; i < 16; ++i) { const int q = lane + 64 * i, kr = q >> 4, c4 = q & 15; LAS float* tp = T + kr * 65 + c4 * 4; tp[0] = v[i][0]; tp[1] = v[i][1]; tp[2] = v[i][2]; tp[3] = v[i][3]; }
    const int nl = lane >> 3, kg = lane & 7;
#pragma unroll
    for (int g = 0; g < 8; ++g) { const int nn = g * 8 + nl; float e[8];
#pragma unroll
        for (int j = 0; j < 8; ++j) e[j] = T[(kg * 8 + j) * 65 + nn];
        u32x4 w; w.x = cvt_pk_bf16(e[0], e[1]); w.y = cvt_pk_bf16(e[2], e[3]); w.z = cvt_pk_bf16(e[4], e[5]); w.w = cvt_pk_bf16(e[6], e[7]);
        *(u32x4*)(dst + (size_t)(n0 + nn) * K + k0 + kg * 8) = w; }
}
__device__ __forceinline__ void tconv(LAS unsigned char* lds, const float* __restrict__ src, int K, int Nsrc, bf16_t* __restrict__ dst, int Ndst,
                                      const float* __restrict__ kscale, bool winmap, int& tbase, int bid, int G) {
    const int wid = threadIdx.x >> 6; const int ntile = (K / 64) * (Ndst / 64);
    LAS float* T = (LAS float*)(lds + wid * 16640);
    const int W = G * 8, me = bid * 8 + wid;
    int first = (me - (tbase % W) + W) % W;
    for (int t = first; t < ntile; t += W) tconv_tile(T, src, K, Nsrc, dst, kscale, winmap, t);
    tbase += ntile;
}
__device__ __forceinline__ void phase0(LAS unsigned char* lds, const P& p, int bid, int G) {
    unsigned char* ws = p.ws; const int tid = threadIdx.x, lane = tid & 63, wid = tid >> 6;
    if (bid == 0 && tid == 0) ((unsigned*)ws)[16] = 0u;
    for (int i = bid * NTHR + tid; i < 2 * 9216; i += G * NTHR) ((float*)(ws + WS_SS1))[i] = 0.f;
    for (int row = bid * 8 + wid; row < 10240; row += G * 8) {
        const float* src = row < 8192 ? p.in[0] + (size_t)row * 2048 : (row < 9216 ? p.in[1] + (size_t)(row - 8192) * 2048 : p.in[2] + (size_t)(row - 9216) * 2048);
        const float* g = row < 9216 ? p.in[9] : p.in[22];
        bf16_t* dst = row < 9216 ? (bf16_t*)(ws + WS_XN) + (size_t)row * 2048 : (bf16_t*)(ws + WS_MEMN) + (size_t)(row - 9216) * 2048;
        f32x4 v[8]; float s = 0.f;
#pragma unroll
        for (int i = 0; i < 8; ++i) { v[i] = *(const f32x4*)(src + (i * 64 + lane) * 4); s += v[i][0] * v[i][0] + v[i][1] * v[i][1] + v[i][2] * v[i][2] + v[i][3] * v[i][3]; }
#pragma unroll
        for (int o = 32; o >= 1; o >>= 1) s += __shfl_xor(s, o);
        const float rs = rsqrtf(s * (1.f / 2048.f) + 1e-6f);
#pragma unroll
        for (int i = 0; i < 8; ++i) { const f32x4 gg = *(const f32x4*)(g + (i * 64 + lane) * 4); const f32x4 y = v[i] * rs * gg;
            u32x2 w; w.x = cvt_pk_bf16(y[0], y[1]); w.y = cvt_pk_bf16(y[2], y[3]); *(u32x2*)(dst + (i * 64 + lane) * 4) = w; }
    }
    int tb = 0;
    tconv(lds, p.in[10], 2048, 13328, (bf16_t*)(ws + WS_WIN), 13568, nullptr, true, tb, bid, G);
    tconv(lds, p.in[23], 2048, 2048, (bf16_t*)(ws + WS_WMKV), 2048, nullptr, false, tb, bid, G);
    for (int nb = 0; nb < 8; ++nb) {
        tconv(lds, p.in[13] + (size_t)nb * 16384, 128, 128, (bf16_t*)(ws + WS_WRG) + (size_t)nb * 32768, 128, nullptr, false, tb, bid, G);
        tconv(lds, p.in[15] + (size_t)nb * 16384, 128, 128, (bf16_t*)(ws + WS_WRG) + (size_t)nb * 32768 + 16384, 128, nullptr, false, tb, bid, G);
    }
}

constexpr int GPC = 36864;
__device__ __forceinline__ void gdn_prep_item(LAS unsigned char* lds, const P& p, int item) {
    const int tid = threadIdx.x, lane = tid & 63, wid = __builtin_amdgcn_readfirstlane(tid >> 6), fr = lane & 15, fq = lane >> 4;
    const int c = item & 31, h = (item >> 5) & 7, b = item >> 8;
    const int tok0 = b * 2048 + c * 64;
    const bf16_t* PROJ = (const bf16_t*)(p.ws + WS_PROJ); const float* GBA = (const float*)(p.ws + WS_GBA);
    bf16_t* gp = (bf16_t*)(p.ws + WS_GP) + (size_t)item * GPC;
    LAS bf16_t* qs = (LAS bf16_t*)(lds + 0);
    LAS bf16_t* ks = (LAS bf16_t*)(lds + 17408);
    LAS bf16_t* vs = (LAS bf16_t*)(lds + 34816);
    LAS float* Mf = (LAS float*)(lds + 52224);
    LAS float* sc = (LAS float*)(lds + 114688);
    __syncthreads();
    if (wid == 0) {
        const float gb = GBA[(size_t)(tok0 + lane) * 16 + h], ga = GBA[(size_t)(tok0 + lane) * 16 + 8 + h];
        const float beta = sigm(gb);
        const float g = -__expf(p.in[19][h]) * softplusf(ga + p.in[20][h]);
        float gc = g;
#pragma unroll
        for (int o = 1; o < 64; o <<= 1) { const float t = __shfl_up(gc, o); if (lane >= o) gc += t; }
        const float gl = __shfl(gc, 63);
        sc[lane] = gc; sc[64 + lane] = beta; sc[128 + lane] = __expf(gc); sc[192 + lane] = __expf(gl - gc); sc[256 + lane] = beta * __expf(gc);
        if (lane == 0) ((float*)(p.ws + WS_DEC))[item] = __expf(gl);
    }
    {
        const int r = tid >> 3, seg = tid & 7;
#pragma unroll
        for (int mat = 0; mat < 3; ++mat) {
            const int chm = mat * 1024 + h * 128 + seg * 16;
            float a[16];
#pragma unroll
            for (int i = 0; i < 16; ++i) a[i] = 0.f;
#pragma unroll
            for (int j = 0; j < 4; ++j) { const int t = c * 64 + r - 3 + j;
                if (t >= 0) { const bf16_t* src = PROJ + (size_t)(b * 2048 + t) * NPROJ + C_GQ + chm; const u32x4 x0 = *(const u32x4*)src, x1 = *(const u32x4*)(src + 8);
                    const float* w = p.in[18] + j * 3072 + chm; const f32x4 w0 = *(const f32x4*)w, w1 = *(const f32x4*)(w + 4), w2 = *(const f32x4*)(w + 8), w3 = *(const f32x4*)(w + 12);
                    a[0] += w0[0] * bf_lo(x0.x); a[1] += w0[1] * bf_hi(x0.x); a[2] += w0[2] * bf_lo(x0.y); a[3] += w0[3] * bf_hi(x0.y);
                    a[4] += w1[0] * bf_lo(x0.z); a[5] += w1[1] * bf_hi(x0.z); a[6] += w1[2] * bf_lo(x0.w); a[7] += w1[3] * bf_hi(x0.w);
                    a[8] += w2[0] * bf_lo(x1.x); a[9] += w2[1] * bf_hi(x1.x); a[10] += w2[2] * bf_lo(x1.y); a[11] += w2[3] * bf_hi(x1.y);
                    a[12] += w3[0] * bf_lo(x1.z); a[13] += w3[1] * bf_hi(x1.z); a[14] += w3[2] * bf_lo(x1.w); a[15] += w3[3] * bf_hi(x1.w); } }
            float ss = 0.f;
#pragma unroll
            for (int i = 0; i < 16; ++i) { a[i] = siluf(a[i]); ss += a[i] * a[i]; }
            if (mat < 2) { ss += __shfl_xor(ss, 1); ss += __shfl_xor(ss, 2); ss += __shfl_xor(ss, 4);
                float rn = rsqrtf(ss + 1e-6f); if (mat == 0) rn *= 0.08838834764831845f;
#pragma unroll
                for (int i = 0; i < 16; ++i) a[i] *= rn; }
            LAS bf16_t* dst = (mat == 0 ? qs : (mat == 1 ? ks : vs)) + r * 136 + seg * 16;
            u32x4 w0, w1; w0.x = cvt_pk_bf16(a[0], a[1]); w0.y = cvt_pk_bf16(a[2], a[3]); w0.z = cvt_pk_bf16(a[4], a[5]); w0.w = cvt_pk_bf16(a[6], a[7]);
            w1.x = cvt_pk_bf16(a[8], a[9]); w1.y = cvt_pk_bf16(a[10], a[11]); w1.z = cvt_pk_bf16(a[12], a[13]); w1.w = cvt_pk_bf16(a[14], a[15]);
            *(LAS u32x4*)dst = w0; *(LAS u32x4*)(dst + 8) = w1;
        }
    }
    LDS_BAR();
    {
        const int r = tid & 63, seg = tid >> 6; const float ed = sc[192 + r];
        bf16_t* kdt = gp + 24576;
#pragma unroll
        for (int i = 0; i < 16; ++i) { const int ch = seg * 16 + i; const float kv = bf2f(ks[r * 136 + ch]);
            kdt[ch * 64 + r] = f2bf(kv * ed); }
    }
    {
        const int r = tid >> 3, seg = tid & 7; const float eg = sc[128 + r];
        const u32x4 x0 = *(const LAS u32x4*)(qs + r * 136 + seg * 16), x1 = *(const LAS u32x4*)(qs + r * 136 + seg * 16 + 8);
        u32x4 w0, w1;
        w0.x = cvt_pk_bf16(bf_lo(x0.x) * eg, bf_hi(x0.x) * eg); w0.y = cvt_pk_bf16(bf_lo(x0.y) * eg, bf_hi(x0.y) * eg); w0.z = cvt_pk_bf16(bf_lo(x0.z) * eg, bf_hi(x0.z) * eg); w0.w = cvt_pk_bf16(bf_lo(x0.w) * eg, bf_hi(x0.w) * eg);
        w1.x = cvt_pk_bf16(bf_lo(x1.x) * eg, bf_hi(x1.x) * eg); w1.y = cvt_pk_bf16(bf_lo(x1.y) * eg, bf_hi(x1.y) * eg); w1.z = cvt_pk_bf16(bf_lo(x1.z) * eg, bf_hi(x1.z) * eg); w1.w = cvt_pk_bf16(bf_lo(x1.w) * eg, bf_hi(x1.w) * eg);
        bf16_t* d = gp + 8192 + r * 128 + seg * 16; *(u32x4*)d = w0; *(u32x4*)(d + 8) = w1;
    }
    {
        bf16_t* at = gp + 32768;
#pragma unroll
        for (int i4 = 0; i4 < 4; ++i4) { const int T = wid * 4 + i4, which = T >> 4, it = (T >> 2) & 3, jt = T & 3;
            if (jt <= it) {
                f32x4 acc = (f32x4){0.f, 0.f, 0.f, 0.f}; const LAS bf16_t* A = which ? qs : ks;
                bf16x8 fa[4], fb[4];
#pragma unroll
                for (int k = 0; k < 4; ++k) { fa[k] = *(const LAS bf16x8*)(A + (16 * it + fr) * 136 + 32 * k + fq * 8); fb[k] = *(const LAS bf16x8*)(ks + (16 * jt + fr) * 136 + 32 * k + fq * 8); }
#pragma unroll
                for (int k = 0; k < 4; ++k) acc = MFMA16(fa[k], fb[k], acc);
#pragma unroll
                for (int r = 0; r < 4; ++r) { const int i = 16 * it + fq * 4 + r, j = 16 * jt + fr; const float d = (j <= i) ? __expf(sc[i] - sc[j]) : 0.f;
                    if (!which) { if (j < i) Mf[i * 64 + j] = sc[64 + i] * acc[r] * d; }
                    else at[i * 64 + j] = f2bf(acc[r] * d); }
            } else if (which) {
#pragma unroll
                for (int r = 0; r < 4; ++r) at[(16 * it + fq * 4 + r) * 64 + 16 * jt + fr] = (bf16_t)0;
            }
        }
    }
    LDS_BAR();
    if (wid < 4) {
        const bool isk = wid >= 2; const int col = (wid & 1) * 64 + lane;
        float X[64]; int zoff; asm volatile("v_mov_b32 %0, 0" : "=v"(zoff)); const LAS float* Mz = Mf + zoff; const LAS float* scz = sc + zoff + (isk ? 256 : 64);
        const LAS bf16_t* src = (const LAS bf16_t*)(lds + (isk ? 17408 : 34816)) + col + zoff;
#pragma unroll
        for (int i = 0; i < 64; ++i) {
            f32x4 mrow[(i + 3) / 4 > 0 ? (i + 3) / 4 : 1];
#pragma unroll
            for (int v = 0; v < (i + 3) / 4; ++v) mrow[v] = *(const LAS f32x4*)(Mz + i * 64 + 4 * v);
            float a0 = bf2f(src[i * 136]) * scz[i], a1 = 0.f, a2 = 0.f, a3 = 0.f;
#pragma unroll
            for (int j = 0; j < i; ++j) { const float mv = mrow[j >> 2][j & 3];
                if ((j & 3) == 0) a0 -= mv * X[j]; else if ((j & 3) == 1) a1 -= mv * X[j]; else if ((j & 3) == 2) a2 -= mv * X[j]; else a3 -= mv * X[j]; }
            X[i] = (a0 + a1) + (a2 + a3);
            asm volatile("" ::: "memory");
        }
        if (!isk) {
            bf16_t* d = gp + 16384 + col * 64;
#pragma unroll
            for (int e = 0; e < 8; ++e) { u32x4 w; w.x = cvt_pk_bf16(X[8 * e], X[8 * e + 1]); w.y = cvt_pk_bf16(X[8 * e + 2], X[8 * e + 3]); w.z = cvt_pk_bf16(X[8 * e + 4], X[8 * e + 5]); w.w = cvt_pk_bf16(X[8 * e + 6], X[8 * e + 7]);
                *(u32x4*)(d + 8 * e) = w; }
        } else {
#pragma unroll
            for (int i = 0; i < 64; ++i) gp[i * 128 + col] = f2bf(X[i]);
        }
    }
}

__device__ __forceinline__ void gdn_seq_item(LAS unsigned char* lds, const P& p, int item) {
    const int tid = threadIdx.x, lane = tid & 63, wid = __builtin_amdgcn_readfirstlane(tid >> 6), fr = lane & 15, fq = lane >> 4;
    const int b = item >> 3, h = item & 7;
    const bf16_t* gp = (const bf16_t*)(p.ws + WS_GP) + (size_t)item * 32 * GPC;
    const float* DEC = (const float*)(p.ws + WS_DEC) + item * 32;
    const bf16_t* PROJ = (const bf16_t*)(p.ws + WS_PROJ);
    bf16_t* YG = (bf16_t*)(p.ws + WS_YCAT) + (size_t)9216 * 1024;
    LAS bf16_t* KCD = (LAS bf16_t*)(lds + 0);
    LAS bf16_t* QG = (LAS bf16_t*)(lds + 17408);
    LAS bf16_t* VT = (LAS bf16_t*)(lds + 34816);
    LAS bf16_t* KDT = (LAS bf16_t*)(lds + 53248);
    LAS bf16_t* AT = (LAS bf16_t*)(lds + 71680);
    LAS bf16_t* ST = (LAS bf16_t*)(lds + 80896);
    LAS bf16_t* VNT = (LAS bf16_t*)(lds + 115712);
    LAS float* SSQ = (LAS float*)(lds + 134144);
#if DBG_SEQ_SUM
    { float* so = p.out + O_GSP + (size_t)item * 16384;
      for (int e = tid; e < 16384; e += NTHR) { const int dk = e >> 7, dv = e & 127; float a = 0.f;
          for (int c = 0; c < 32; ++c) { const bf16_t* g = gp + (size_t)c * GPC; a += bf2f(g[(dk & 63) * 128 + dv]) + bf2f(g[16384 + dv * 64 + (dk & 63)]) + bf2f(g[8192 + (dk & 63) * 128 + dv]) + bf2f(g[24576 + dv * 64 + (dk & 63)]) + bf2f(g[32768 + (dk & 63) * 64 + (dv & 63)]) + DEC[c]; }
          so[e] = a; }
      for (int e = tid; e < 2048 * 128; e += NTHR) YG[((size_t)b * 2048 + (e >> 7)) * 1024 + h * 128 + (e & 127)] = 0;
      return; }
#endif
    u32x4 pf[9];
#define GS_LOAD(cc) do { _Pragma("unroll") for (int i = 0; i < 9; ++i) pf[i] = *(const u32x4*)(gp + (size_t)(cc) * GPC + (size_t)(tid + NTHR * i) * 8); } while (0)
#define GS_STORE() do { _Pragma("unroll") for (int i = 0; i < 9; ++i) { const int q = tid + NTHR * i; int off; \
        if (i < 2) off = 0 + (q >> 4) * 272 + (q & 15) * 16; else if (i < 4) off = 17408 + ((q - 1024) >> 4) * 272 + (q & 15) * 16; \
        else if (i < 6) off = 34816 + ((q - 2048) >> 3) * 144 + (q & 7) * 16; else if (i < 8) off = 53248 + ((q - 3072) >> 3) * 144 + (q & 7) * 16; \
        else off = 71680 + ((q - 4096) >> 3) * 144 + (q & 7) * 16; \
        *(LAS u32x4*)(lds + off) = pf[i]; } } while (0)
    __syncthreads();
    GS_LOAD(0);
    for (int i = tid; i < 34816 / 16; i += NTHR) *(LAS u32x4*)(lds + 80896 + i * 16) = (u32x4){0u, 0u, 0u, 0u};
    GS_STORE();
    f32x4 Sacc[8];
#pragma unroll
    for (int i = 0; i < 8; ++i) Sacc[i] = (f32x4){0.f, 0.f, 0.f, 0.f};
    __syncthreads();
    const int it = wid & 3, dvb = (wid >> 2) * 4;
    for (int c = 0; c < 32; ++c) {
        if (c + 1 < 32) GS_LOAD(c + 1);
        const float dec = DEC[c];
        u32x2 zpf[4];
        { const size_t gt = (size_t)b * 2048 + c * 64 + 16 * it + fr;
#pragma unroll
          for (int q = 0; q < 4; ++q) zpf[q] = *(const u32x2*)(PROJ + gt * NPROJ + C_GZ + h * 128 + 16 * (dvb + q) + fq * 4); }
        {
            bf16x8 a[4];
#pragma unroll
            for (int k = 0; k < 4; ++k) a[k] = *(const LAS bf16x8*)(KCD + (16 * it + fr) * 136 + 32 * k + fq * 8);
            bf16x8 sb[4][4]; u32x2 vvq[4];
#pragma unroll
            for (int q = 0; q < 4; ++q) {
#pragma unroll
                for (int k = 0; k < 4; ++k) sb[q][k] = *(const LAS bf16x8*)(ST + (16 * (dvb + q) + fr) * 136 + 32 * k + fq * 8);
                vvq[q] = *(const LAS u32x2*)(VT + (16 * (dvb + q) + fr) * 72 + 16 * it + fq * 4); }
#pragma unroll
            for (int q = 0; q < 4; ++q) { const int dvt = dvb + q; f32x4 acc = (f32x4){0.f, 0.f, 0.f, 0.f};
#pragma unroll
                for (int k = 0; k < 4; ++k) acc = MFMA16(a[k], sb[q][k], acc);
                const u32x2 vv = vvq[q];
                u32x2 w; w.x = cvt_pk_bf16(bf_lo(vv.x) - acc[0], bf_hi(vv.x) - acc[1]); w.y = cvt_pk_bf16(bf_lo(vv.y) - acc[2], bf_hi(vv.y) - acc[3]);
                *(LAS u32x2*)(VNT + (16 * dvt + fr) * 72 + 16 * it + fq * 4) = w; }
        }
        LDS_BAR();
        f32x4 oacc[4];
        {
            bf16x8 bq[4], ba[2];
#pragma unroll
            for (int k = 0; k < 4; ++k) bq[k] = *(const LAS bf16x8*)(QG + (16 * it + fr) * 136 + 32 * k + fq * 8);
#pragma unroll
            for (int k = 0; k < 2; ++k) ba[k] = *(const LAS bf16x8*)(AT + (16 * it + fr) * 72 + 32 * k + fq * 8);
            float s = 0.f;
#pragma unroll
            for (int q2 = 0; q2 < 4; q2 += 2) {
              bf16x8 sa[2][4], va[2][2];
#pragma unroll
              for (int e = 0; e < 2; ++e) {
#pragma unroll
                for (int k = 0; k < 4; ++k) sa[e][k] = *(const LAS bf16x8*)(ST + (16 * (dvb + q2 + e) + fr) * 136 + 32 * k + fq * 8);
#pragma unroll
                for (int k = 0; k < 2; ++k) va[e][k] = *(const LAS bf16x8*)(VNT + (16 * (dvb + q2 + e) + fr) * 72 + 32 * k + fq * 8); }
#pragma unroll
              for (int e = 0; e < 2; ++e) { const int q = q2 + e; f32x4 acc = (f32x4){0.f, 0.f, 0.f, 0.f};
#pragma unroll
                for (int k = 0; k < 4; ++k) acc = MFMA16(sa[e][k], bq[k], acc);
#pragma unroll
                for (int k = 0; k < 2; ++k) acc = MFMA16(va[e][k], ba[k], acc);
                oacc[q] = acc; s += acc[0] * acc[0] + acc[1] * acc[1] + acc[2] * acc[2] + acc[3] * acc[3]; }
            }
            s += __shfl_xor(s, 16); s += __shfl_xor(s, 32);
            if (fq == 0) SSQ[(wid >> 2) * 64 + 16 * it + fr] = s;
        }
        {
            bf16x8 a[2];
#pragma unroll
            for (int k = 0; k < 2; ++k) a[k] = *(const LAS bf16x8*)(KDT + (16 * wid + fr) * 72 + 32 * k + fq * 8);
            bf16x8 vb[8][2];
#pragma unroll
            for (int dvt = 0; dvt < 8; ++dvt)
#pragma unroll
                for (int k = 0; k < 2; ++k) vb[dvt][k] = *(const LAS bf16x8*)(VNT + (16 * dvt + fr) * 72 + 32 * k + fq * 8);
#pragma unroll
            for (int dvt = 0; dvt < 8; ++dvt) { f32x4 acc = Sacc[dvt] * dec;
#pragma unroll
                for (int k = 0; k < 2; ++k) acc = MFMA16(a[k], vb[dvt][k], acc);
                Sacc[dvt] = acc; }
        }
        LDS_BAR();
        {
#pragma unroll
            for (int dvt = 0; dvt < 8; ++dvt) { u32x2 w; w.x = cvt_pk_bf16(Sacc[dvt][0], Sacc[dvt][1]); w.y = cvt_pk_bf16(Sacc[dvt][2], Sacc[dvt][3]);
                *(LAS u32x2*)(ST + (16 * dvt + fr) * 136 + 16 * wid + fq * 4) = w; }
            const float tot = SSQ[16 * it + fr] + SSQ[64 + 16 * it + fr]; const float rs = rsqrtf(tot * (1.f / 128.f) + 1e-6f);
            const size_t gtok = (size_t)b * 2048 + c * 64 + 16 * it + fr;
#pragma unroll
            for (int q = 0; q < 4; ++q) { const int dv = 16 * (dvb + q) + fq * 4;
                const u32x2 z = zpf[q]; const f32x4 gn = *(const f32x4*)(p.in[21] + dv);
                u32x2 w; w.x = cvt_pk_bf16(DBGFIN(oacc[q][0] * rs * gn[0] * bf_lo(z.x)), DBGFIN(oacc[q][1] * rs * gn[1] * bf_hi(z.x)));
                w.y = cvt_pk_bf16(DBGFIN(oacc[q][2] * rs * gn[2] * bf_lo(z.y)), DBGFIN(oacc[q][3] * rs * gn[3] * bf_hi(z.y)));
                *(u32x2*)(YG + gtok * 1024 + h * 128 + dv) = w; }
            if (c + 1 < 32) GS_STORE();
        }
        LDS_BAR();
    }
    {
        float* so = p.out + O_GSP + (size_t)item * 16384;
#pragma unroll
        for (int dvt = 0; dvt < 8; ++dvt)
#pragma unroll
            for (int r = 0; r < 4; ++r) so[(16 * wid + fq * 4 + r) * 128 + 16 * dvt + fr] = Sacc[dvt][r];
    }
#undef GS_LOAD
#undef GS_STORE
}

template <bool PROMPT>
__device__ __forceinline__ void rglru_item(LAS unsigned char* lds, const P& p, int item) {
    const int tid = threadIdx.x, lane = tid & 63, wid = __builtin_amdgcn_readfirstlane(tid >> 6), fr = lane & 15, fq = lane >> 4;
    const int q = item & 3, n = (item >> 2) & 7, bb0 = item >> 5;
    const int gq0 = n * 128 + 32 * q;
    const bf16_t* PROJ = (const bf16_t*)(p.ws + WS_PROJ);
    bf16_t* YR = (bf16_t*)(p.ws + WS_YCAT);
    LAS bf16_t* WL = (LAS bf16_t*)(lds + 0);
    LAS bf16_t* XA = (LAS bf16_t*)(lds + 17408);
    LAS bf16_t* RG = (LAS bf16_t*)(lds + 52224);
    LAS float* WT = (LAS float*)(lds + 62464);
    LAS float* HC = (LAS float*)(lds + 64512);
    LAS float* PAR = (LAS float*)(lds + 64768);
    __syncthreads();
    {   const bf16_t* wsrc = (const bf16_t*)(p.ws + WS_WRG) + (size_t)n * 32768;
#pragma unroll
        for (int i = 0; i < 2; ++i) { const int c = tid + NTHR * i, r = c >> 4, c8 = c & 15; const int srow = (r < 32) ? (32 * q + r) : (128 + 32 * q + (r - 32));
            *(LAS u32x4*)(WL + r * 136 + c8 * 8) = *(const u32x4*)(wsrc + (size_t)srow * 128 + c8 * 8); }
        if (tid < 64) HC[tid] = 0.f;
        if (tid < 32) { PAR[tid] = p.in[14][gq0 + tid]; PAR[32 + tid] = p.in[16][gq0 + tid]; PAR[64 + tid] = -8.f * softplusf(-p.in[17][gq0 + tid]); } }
    const int ntile = PROMPT ? 16 : 1;
    const int crow = tid >> 2, cpart = tid & 3;
    const int cg = tid & 15, r0 = (tid >> 4) * 4;
    const int gc8 = n * 128 + 8 * cg;
    f32x4 wlo[4], whi[4], blo, bhi;
#pragma unroll
    for (int j = 0; j < 4; ++j) { wlo[j] = *(const f32x4*)(p.in[11] + j * 1024 + gc8); whi[j] = *(const f32x4*)(p.in[11] + j * 1024 + gc8 + 4); }
    blo = *(const f32x4*)(p.in[12] + gc8); bhi = *(const f32x4*)(p.in[12] + gc8 + 4);
    u32x4 xr[7], rgv;
#define RG_LOAD(TT) do { const size_t gr_ = PROMPT ? (size_t)bb0 * 2048 + (TT) * 128 + crow : (size_t)8192 + bb0 * 128 + crow; \
        rgv = *(const u32x4*)(PROJ + gr_ * NPROJ + C_RG + gq0 + 8 * cpart); \
        _Pragma("unroll") for (int k = 0; k < 7; ++k) { const int t_ = PROMPT ? (TT) * 128 + r0 - 3 + k : (r0 & 7) - 3 + k; const int tc_ = t_ > 0 ? t_ : 0; \
            const size_t sr_ = PROMPT ? (size_t)bb0 * 2048 + tc_ : (size_t)8192 + (bb0 * 16 + (r0 >> 3)) * 8 + tc_; \
            xr[k] = *(const u32x4*)(PROJ + sr_ * NPROJ + C_RX + gc8); } } while (0)
    RG_LOAD(0);
    for (int tt = 0; tt < ntile; ++tt) {
        const size_t grow_c = PROMPT ? (size_t)bb0 * 2048 + tt * 128 + crow : (size_t)8192 + bb0 * 128 + crow;
        {
#pragma unroll
            for (int rr = 0; rr < 4; ++rr) { f32x4 alo = blo, ahi = bhi;
#pragma unroll
                for (int j = 0; j < 4; ++j) { const int t = PROMPT ? tt * 128 + r0 + rr - 3 + j : (r0 & 7) + rr - 3 + j;
                    if (t >= 0) { const u32x4 x = xr[rr + j];
                        alo[0] += wlo[j][0] * bf_lo(x.x); alo[1] += wlo[j][1] * bf_hi(x.x); alo[2] += wlo[j][2] * bf_lo(x.y); alo[3] += wlo[j][3] * bf_hi(x.y);
                        ahi[0] += whi[j][0] * bf_lo(x.z); ahi[1] += whi[j][1] * bf_hi(x.z); ahi[2] += whi[j][2] * bf_lo(x.w); ahi[3] += whi[j][3] * bf_hi(x.w);
                    } else if (!PROMPT) { const float* srcf = p.in[5] + (size_t)((bb0 * 16 + (r0 >> 3)) * 3 + 3 + t) * 1024 + gc8;
                        const f32x4 x0 = *(const f32x4*)srcf, x1 = *(const f32x4*)(srcf + 4); alo += wlo[j] * x0; ahi += whi[j] * x1; }
                }
                u32x4 w; w.x = cvt_pk_bf16(alo[0], alo[1]); w.y = cvt_pk_bf16(alo[2], alo[3]); w.z = cvt_pk_bf16(ahi[0], ahi[1]); w.w = cvt_pk_bf16(ahi[2], ahi[3]);
                *(LAS u32x4*)(XA + (r0 + rr) * 136 + 8 * cg) = w; }
            *(LAS u32x4*)(RG + crow * 40 + 8 * cpart) = rgv;
            if (tt + 1 < ntile) RG_LOAD(tt + 1);
        }
        LDS_BAR();
        f32x4 acc[4];
        {   bf16x8 a[4];
#pragma unroll
            for (int k = 0; k < 4; ++k) a[k] = *(const LAS bf16x8*)(XA + (16 * wid + fr) * 136 + 32 * k + fq * 8);
            bf16x8 wf[4][4];
#pragma unroll
            for (int nt = 0; nt < 4; ++nt)
#pragma unroll
                for (int k = 0; k < 4; ++k) wf[nt][k] = *(const LAS bf16x8*)(WL + (16 * nt + fr) * 136 + 32 * k + fq * 8);
#pragma unroll
            for (int nt = 0; nt < 4; ++nt) { f32x4 c = (f32x4){0.f, 0.f, 0.f, 0.f};
#pragma unroll
                for (int k = 0; k < 4; ++k) c = MFMA16(a[k], wf[nt][k], c);
                acc[nt] = c; } }
        float eA[2], eU[2]; float xcv[2][4], pbx[2], pba[2], pc8[2];
#pragma unroll
        for (int nt = 0; nt < 2; ++nt) { const int ch = 16 * nt + fr; pbx[nt] = PAR[ch]; pba[nt] = PAR[32 + ch]; pc8[nt] = PAR[64 + ch];
#pragma unroll
            for (int r = 0; r < 4; ++r) xcv[nt][r] = bf2f(XA[(16 * wid + 4 * fq + r) * 136 + 32 * q + ch]); }
#pragma unroll
        for (int nt = 0; nt < 2; ++nt) { const int ch = 16 * nt + fr;
            const float bx = pbx[nt], ba = pba[nt], c8 = pc8[nt];
#pragma unroll
            for (int r = 0; r < 4; ++r) { const float gi = sigm(acc[nt][r] + bx), gr = sigm(acc[nt + 2][r] + ba); const float la = c8 * gr;
                const float av = __expf(la), mult = sqrtf(fmaxf(1.f - av * av, 0.f)); const float xc = xcv[nt][r];
                acc[nt][r] = mult * gi * xc; acc[nt + 2][r] = av; }
            float A = acc[nt + 2][0], U = acc[nt][0];
#pragma unroll
            for (int r = 1; r < 4; ++r) { U = acc[nt + 2][r] * U + acc[nt][r]; A *= acc[nt + 2][r]; }
            if (PROMPT) {
                float A1 = __shfl_up(A, 16), U1 = __shfl_up(U, 16); if (fq >= 1) { U = A * U1 + U; A = A * A1; }
                A1 = __shfl_up(A, 32); U1 = __shfl_up(U, 32); if (fq >= 2) { U = A * U1 + U; A = A * A1; }
                float Ae = __shfl_up(A, 16), Ue = __shfl_up(U, 16); if (fq == 0) { Ae = 1.f; Ue = 0.f; }
                eA[nt] = Ae; eU[nt] = Ue;
                if (fq == 3) { WT[(wid * 32 + ch) * 2] = A; WT[(wid * 32 + ch) * 2 + 1] = U; }
            } else {
                float Ae = __shfl_up(A, 16), Ue = __shfl_up(U, 16); if ((fq & 1) == 0) { Ae = 1.f; Ue = 0.f; }
                eA[nt] = Ae; eU[nt] = Ue;
            }
        }
        LDS_BAR();
#pragma unroll
        for (int nt = 0; nt < 2; ++nt) { const int ch = 16 * nt + fr, gch = gq0 + ch;
            float hv;
            if (PROMPT) { hv = HC[(tt & 1) * 32 + ch];
                for (int w2 = 0; w2 < wid; ++w2) hv = WT[(w2 * 32 + ch) * 2] * hv + WT[(w2 * 32 + ch) * 2 + 1];
            } else hv = p.in[6][(size_t)(bb0 * 16 + wid * 2 + (fq >> 1)) * 1024 + gch];
            hv = eA[nt] * hv + eU[nt];
#pragma unroll
            for (int r = 0; r < 4; ++r) { hv = acc[nt + 2][r] * hv + acc[nt][r];
                LAS bf16_t* e = RG + (16 * wid + 4 * fq + r) * 40 + ch; *e = f2bf(hv * bf2f(*e)); }
            if (PROMPT) { if (wid == 7 && fq == 3) { HC[((tt & 1) ^ 1) * 32 + ch] = hv; if (tt == 15) p.out[O_RHP + (size_t)bb0 * 1024 + gch] = hv; } }
            else { if (fq & 1) p.out[O_RHS + (size_t)(bb0 * 16 + wid * 2 + (fq >> 1)) * 1024 + gch] = hv; }
        }
        LDS_BAR();
        *(u32x4*)(YR + grow_c * 1024 + gq0 + 8 * cpart) = *(const LAS u32x4*)(RG + crow * 40 + 8 * cpart);
    }
#undef RG_LOAD
}

__device__ __forceinline__ void gdn_sample_pass(LAS unsigned char* lds, const P& p, int pass) {
    const int tid = threadIdx.x, lane = tid & 63, sub = tid >> 8, idx = tid & 255, v = idx >> 1, kh = idx & 1, wv = (tid >> 6) & 3;
    const int item = pass * 2 + sub, b = item >> 3, h = item & 7;
    const bf16_t* PROJ = (const bf16_t*)(p.ws + WS_PROJ); const float* GBA = (const float*)(p.ws + WS_GBA);
    bf16_t* YG = (bf16_t*)(p.ws + WS_YCAT) + (size_t)9216 * 1024;
    LAS float* qv = (LAS float*)(lds + sub * 16896);
    LAS float* kv = qv + 1024;
    LAS float* vv = kv + 1024;
    LAS float* ov = vv + 1024;
    LAS float* red = ov + 1024;
    LAS float* db = red + 96;
    __syncthreads();
    {
        float yq[8], yk[8];
#pragma unroll
        for (int mat = 0; mat < 3; ++mat) { const int ch = mat * 1024 + h * 128 + v; float x[11];
#pragma unroll
            for (int j = 0; j < 3; ++j) x[j] = p.in[7][(size_t)(b * 3 + j) * 3072 + ch];
#pragma unroll
            for (int t = 0; t < 8; ++t) x[3 + t] = bf2f(PROJ[(size_t)(8192 + b * 8 + t) * NPROJ + C_GQ + ch]);
            const float w0 = p.in[18][ch], w1 = p.in[18][3072 + ch], w2 = p.in[18][6144 + ch], w3 = p.in[18][9216 + ch];
#pragma unroll
            for (int t = 0; t < 8; ++t) { const float y = siluf(w0 * x[t] + w1 * x[t + 1] + w2 * x[t + 2] + w3 * x[t + 3]); if (mat == 0) yq[t] = y; else if (mat == 1) yk[t] = y; else if (kh == 0) vv[t * 128 + v] = y; } }
#pragma unroll
        for (int t = 0; t < 8; ++t) { float sq = kh ? 0.f : yq[t] * yq[t], sk = kh ? 0.f : yk[t] * yk[t];
#pragma unroll
            for (int o = 32; o >= 1; o >>= 1) { sq += __shfl_xor(sq, o); sk += __shfl_xor(sk, o); }
            if (lane == 0) { red[wv * 8 + t] = sq; red[32 + wv * 8 + t] = sk; } }
        if (idx < 8) { const float* gr = GBA + (size_t)(8192 + b * 8 + idx) * 16; db[8 + idx] = sigm(gr[h]); db[idx] = __expf(-__expf(p.in[19][h]) * softplusf(gr[8 + h] + p.in[20][h])); }
        __syncthreads();
        if (kh == 0) {
#pragma unroll
            for (int t = 0; t < 8; ++t) { const float rq = rsqrtf(red[t] + red[8 + t] + red[16 + t] + red[24 + t] + 1e-6f) * 0.08838834764831845f, rk = rsqrtf(red[32 + t] + red[40 + t] + red[48 + t] + red[56 + t] + 1e-6f);
                qv[t * 128 + v] = yq[t] * rq; kv[t * 128 + v] = yk[t] * rk; } }
    }
    float Sc[64];
    { const float* s0 = p.in[8] + (size_t)item * 16384 + (size_t)kh * 64 * 128 + v;
#pragma unroll
        for (int k = 0; k < 64; ++k) Sc[k] = s0[k * 128]; }
    __syncthreads();
#pragma unroll 1
    for (int t = 0; t < 8; ++t) {
        const float dect = db[t], betat = db[8 + t], vt = vv[t * 128 + v];
        const LAS float* kt = kv + t * 128 + kh * 64; const LAS float* qt = qv + t * 128 + kh * 64;
        f32x4 kreg[16];
#pragma unroll
        for (int k = 0; k < 16; ++k) kreg[k] = *(const LAS f32x4*)(kt + 4 * k);
        float d0 = 0.f, d1 = 0.f, d2 = 0.f, d3 = 0.f;
#pragma unroll
        for (int k = 0; k < 64; k += 4) { const f32x4 kk = kreg[k >> 2]; d0 += Sc[k] * kk[0]; d1 += Sc[k + 1] * kk[1]; d2 += Sc[k + 2] * kk[2]; d3 += Sc[k + 3] * kk[3]; }
        float dot = (d0 + d1) + (d2 + d3); dot += __shfl_xor(dot, 1);
        const float rr = betat * (vt - dect * dot);
        float o0 = 0.f, o1 = 0.f, o2 = 0.f, o3 = 0.f;
#pragma unroll
        for (int hh = 0; hh < 2; ++hh) { f32x4 qreg[8];
#pragma unroll
            for (int k = 0; k < 8; ++k) qreg[k] = *(const LAS f32x4*)(qt + 32 * hh + 4 * k);
#pragma unroll
            for (int k8 = 0; k8 < 8; ++k8) { const int k = 32 * hh + 4 * k8; const f32x4 kk = kreg[k >> 2], qq = qreg[k8];
                Sc[k] = dect * Sc[k] + kk[0] * rr; Sc[k + 1] = dect * Sc[k + 1] + kk[1] * rr; Sc[k + 2] = dect * Sc[k + 2] + kk[2] * rr; Sc[k + 3] = dect * Sc[k + 3] + kk[3] * rr;
                o0 += Sc[k] * qq[0]; o1 += Sc[k + 1] * qq[1]; o2 += Sc[k + 2] * qq[2]; o3 += Sc[k + 3] * qq[3]; } }
        float ot = (o0 + o1) + (o2 + o3); ot += __shfl_xor(ot, 1);
        if (kh == 0) ov[t * 128 + v] = ot;
    }
    { float* so = p.out + O_GSS + (size_t)item * 16384 + (size_t)kh * 64 * 128 + v;
#pragma unroll
        for (int k = 0; k < 64; ++k) so[k * 128] = Sc[k]; }
    __syncthreads();
#pragma unroll
    for (int t = 0; t < 8; ++t) { const float ot = ov[t * 128 + v]; float s = kh ? 0.f : ot * ot;
#pragma unroll
        for (int oo = 32; oo >= 1; oo >>= 1) s += __shfl_xor(s, oo);
        if (lane == 0) red[64 + wv * 8 + t] = s; }
    __syncthreads();
    if (kh == 0) {
        const float gn = p.in[21][v];
#pragma unroll
        for (int t = 0; t < 8; ++t) { const float rs = rsqrtf((red[64 + t] + red[72 + t] + red[80 + t] + red[88 + t]) * (1.f / 128.f) + 1e-6f); const size_t grow = (size_t)8192 + b * 8 + t;
            const float z = bf2f(PROJ[grow * NPROJ + C_GZ + h * 128 + v]);
            YG[grow * 1024 + h * 128 + v] = f2bf(ov[t * 128 + v] * rs * gn * z); } }
}

template <bool F32SRC>
__device__ __forceinline__ void attn_stage(LAS unsigned char* lds, const void* src, int half) {
    const int tid = threadIdx.x;
    if (F32SRC) { const float* s = (const float*)src + (size_t)half * 128 * 1024; f32x4 a[8], b[8];
#pragma unroll
        for (int i = 0; i < 8; ++i) { const int q = tid + NTHR * i; const float* g = s + (size_t)(q >> 5) * 1024 + (q & 31) * 8; a[i] = *(const f32x4*)g; b[i] = *(const f32x4*)(g + 4); }
#pragma unroll
        for (int i = 0; i < 8; ++i) { const int q = tid + NTHR * i; u32x4 w; w.x = cvt_pk_bf16(a[i][0], a[i][1]); w.y = cvt_pk_bf16(a[i][2], a[i][3]); w.z = cvt_pk_bf16(b[i][0], b[i][1]); w.w = cvt_pk_bf16(b[i][2], b[i][3]);
            *(LAS u32x4*)(lds + (q >> 5) * 528 + (q & 31) * 16) = w; }
    } else { const bf16_t* s = (const bf16_t*)src + (size_t)half * 128 * 1024; u32x4 a[8];
#pragma unroll
        for (int i = 0; i < 8; ++i) { const int q = tid + NTHR * i; a[i] = *(const u32x4*)(s + (size_t)(q >> 5) * 1024 + (q & 31) * 8); }
#pragma unroll
        for (int i = 0; i < 8; ++i) { const int q = tid + NTHR * i; *(LAS u32x4*)(lds + (q >> 5) * 528 + (q & 31) * 16) = a[i]; }
    }
}
template <bool F32SRC>
__device__ __forceinline__ void attn_item(LAS unsigned char* lds, const bf16_t* Q, int nrows, const void* Kb, const void* Vb, bf16_t* O) {
    const int tid = threadIdx.x, lane = tid & 63, wid = __builtin_amdgcn_readfirstlane(tid >> 6), fr = lane & 15, fq = lane >> 4;
    const bool active = (16 * wid < nrows);
    LAS unsigned char* PSw = lds + 69632 + wid * 8448;
    __syncthreads();
    bf16x8 qf[8];
    { const int row = min(16 * wid + fr, nrows - 1);
#pragma unroll
        for (int k = 0; k < 8; ++k) qf[k] = *(const bf16x8*)(Q + (size_t)row * NPROJ + 32 * k + fq * 8); }
    f32x4 sacc[16];
#pragma unroll
    for (int i = 0; i < 16; ++i) sacc[i] = (f32x4){0.f, 0.f, 0.f, 0.f};
#pragma unroll
    for (int half = 0; half < 2; ++half) {
        attn_stage<F32SRC>(lds, Kb, half);
        __syncthreads();
        if (active) {
#pragma unroll
            for (int mt = 0; mt < 8; mt += 2) { bf16x8 kf[2][8];
#pragma unroll
                for (int e = 0; e < 2; ++e)
#pragma unroll
                    for (int k = 0; k < 8; ++k) kf[e][k] = *(const LAS bf16x8*)(lds + (16 * (mt + e) + fr) * 528 + (32 * k + fq * 8) * 2);
#pragma unroll
                for (int e = 0; e < 2; ++e)
#pragma unroll
                    for (int k = 0; k < 8; ++k) sacc[half * 8 + mt + e] = MFMA16(kf[e][k], qf[k], sacc[half * 8 + mt + e]); }
        }
        __syncthreads();
    }
    if (active) {
        float mx = -3.0e38f;
#pragma unroll
        for (int mt = 0; mt < 16; ++mt)
#pragma unroll
            for (int r = 0; r < 4; ++r) mx = fmaxf(mx, sacc[mt][r]);
        mx = fmaxf(mx, __shfl_xor(mx, 16)); mx = fmaxf(mx, __shfl_xor(mx, 32));
        float sum = 0.f;
#pragma unroll
        for (int mt = 0; mt < 16; ++mt)
#pragma unroll
            for (int r = 0; r < 4; ++r) { const float e = __expf((sacc[mt][r] - mx) * 0.0625f); sacc[mt][r] = e; sum += e; }
        sum += __shfl_xor(sum, 16); sum += __shfl_xor(sum, 32);
        const float inv = 1.f / sum;
#pragma unroll
        for (int mt = 0; mt < 16; ++mt) { u32x2 w; w.x = cvt_pk_bf16(sacc[mt][0] * inv, sacc[mt][1] * inv); w.y = cvt_pk_bf16(sacc[mt][2] * inv, sacc[mt][3] * inv);
            *(LAS u32x2*)(PSw + fr * 528 + (16 * mt + 4 * fq) * 2) = w; }
    }
    f32x4 oacc[16];
#pragma unroll
    for (int i = 0; i < 16; ++i) oacc[i] = (f32x4){0.f, 0.f, 0.f, 0.f};
#pragma unroll
    for (int half = 0; half < 2; ++half) {
        attn_stage<F32SRC>(lds, Vb, half);
        __syncthreads();
        if (active) {
#pragma unroll
            for (int k = 0; k < 4; ++k) { const bf16x8 pfrag = *(const LAS bf16x8*)(PSw + fr * 528 + (128 * half + 32 * k + fq * 8) * 2);
#pragma unroll
                for (int d0 = 0; d0 < 16; d0 += 8) { s16x4 lo[8], hi[8];
#pragma unroll
                    for (int e = 0; e < 8; ++e) { LAS unsigned char* va = lds + (32 * k + 8 * fq + (fr >> 2)) * 528 + (16 * (d0 + e) + 4 * (fr & 3)) * 2;
                        lo[e] = __builtin_amdgcn_ds_read_tr16_b64_v4i16((LAS s16x4*)va); hi[e] = __builtin_amdgcn_ds_read_tr16_b64_v4i16((LAS s16x4*)(va + 4 * 528)); }
#pragma unroll
                    for (int e = 0; e < 8; ++e) { bf16x8 vf; vf[0] = lo[e][0]; vf[1] = lo[e][1]; vf[2] = lo[e][2]; vf[3] = lo[e][3]; vf[4] = hi[e][0]; vf[5] = hi[e][1]; vf[6] = hi[e][2]; vf[7] = hi[e][3];
                        oacc[d0 + e] = MFMA16(vf, pfrag, oacc[d0 + e]); } } }
        }
        __syncthreads();
    }
    if (active && 16 * wid + fr < nrows) {
        bf16_t* op = O + (size_t)(16 * wid + fr) * 1024 + 4 * fq;
#pragma unroll
        for (int dt = 0; dt < 16; ++dt) { u32x2 w; w.x = cvt_pk_bf16(oacc[dt][0], oacc[dt][1]); w.y = cvt_pk_bf16(oacc[dt][2], oacc[dt][3]); *(u32x2*)(op + 16 * dt) = w; }
    }
}

__device__ __forceinline__ void conv_states(const P& p, int bid, int G) {
    const bf16_t* PROJ = (const bf16_t*)(p.ws + WS_PROJ);
    const int total = 12288 + 36864 + 393216 + 1179648;
    for (int i = bid * NTHR + threadIdx.x; i < total; i += G * NTHR) {
        int e = i; size_t oo; int bj, ch, col0, W; size_t rowbase; int T;
        if (e < 12288) { oo = O_RCP; W = 1024; col0 = C_RX; T = 2048; rowbase = 0; }
        else if ((e -= 12288) < 36864) { oo = O_GCP; W = 3072; col0 = C_GQ; T = 2048; rowbase = 0; }
        else if ((e -= 36864) < 393216) { oo = O_RCS; W = 1024; col0 = C_RX; T = 8; rowbase = 8192; }
        else { e -= 393216; oo = O_GCS; W = 3072; col0 = C_GQ; T = 8; rowbase = 8192; }
        bj = e / W; ch = e - bj * W; const int b = bj / 3, j = bj - b * 3;
        p.out[oo + e] = bf2f(PROJ[(rowbase + (size_t)b * T + (T - 3 + j)) * NPROJ + col0 + ch]);
    }
}


#ifndef DBG_CHECK
#define DBG_CHECK 1
#endif
__device__ __forceinline__ float blk_sum(LAS float* red, float v) {
    __syncthreads();
#pragma unroll
    for (int o = 32; o >= 1; o >>= 1) v += __shfl_xor(v, o);
    if ((threadIdx.x & 63) == 0) red[threadIdx.x >> 6] = v;
    __syncthreads();
    float t = 0.f;
#pragma unroll
    for (int i = 0; i < 8; ++i) t += red[i];
    return t;
}
__device__ __forceinline__ void dbg_flag(const P& p, unsigned id) { atomicMax((unsigned*)p.ws, id); }
__global__ void __launch_bounds__(NTHR) dbg_check_gemm1(P p) {
    __shared__ float red_s[8]; LAS float* red = (LAS float*)red_s; const int tid = threadIdx.x, bid = blockIdx.x;
    for (int s = bid; s < 1024; s += gridDim.x) {
        const int row = (s * 37 + 11) % 9216; const int oc = (int)(((long)s * 5303 + 7) % 13328);
        const int pc = oc < 6144 ? oc : (oc < 6160 ? 13312 + (oc - 6144) : oc - 16);
        const float* x = row < 8192 ? p.in[0] + (size_t)row * 2048 : p.in[1] + (size_t)(row - 8192) * 2048;
        float ss = 0.f, dot = 0.f;
        for (int k = tid; k < 2048; k += NTHR) { const float xv = x[k]; ss += xv * xv; dot += xv * p.in[9][k] * p.in[10][(size_t)k * 13328 + oc]; }
        ss = blk_sum(red, ss); dot = blk_sum(red, dot);
        float ref = dot * rsqrtf(ss * (1.f / 2048.f) + 1e-6f);
        const int pn = pc >> 8; const int act = (pn >= 4 && pn < 8) ? 1 : (pn >= 20 && pn < 24) ? 2 : (pn >= 28 && pn < 52) ? 3 : 0;
        float got;
        if (pc >= 13312) got = ((const float*)(p.ws + WS_GBA))[(size_t)row * 16 + (pc - 13312)];
        else { got = bf2f(((const bf16_t*)(p.ws + WS_PROJ))[(size_t)row * NPROJ + pc]); if (act) ref = actf(ref, act); }
        if (tid == 0 && !(fabsf(got - ref) <= 0.03f + 0.03f * fabsf(ref))) dbg_flag(p, 1u + (unsigned)(pn >= 52 ? 5 : pn >= 28 ? 4 : pn >= 24 ? 3 : pn >= 8 ? 2 : pn >= 4 ? 1 : 0));
    }
    for (int s = bid; s < 256; s += gridDim.x) {
        const int row = (s * 29 + 3) % 1024; const int oc = (s * 523 + 5) % 2048;
        const float* x = p.in[2] + (size_t)row * 2048;
        float ss = 0.f, dot = 0.f;
        for (int k = tid; k < 2048; k += NTHR) { const float xv = x[k]; ss += xv * xv; dot += xv * p.in[22][k] * p.in[23][(size_t)k * 2048 + oc]; }
        ss = blk_sum(red, ss); dot = blk_sum(red, dot);
        const float ref = dot * rsqrtf(ss * (1.f / 2048.f) + 1e-6f);
        const float got = oc < 1024 ? p.out[O_MK + (size_t)row * 1024 + oc] : p.out[O_MV + (size_t)row * 1024 + oc - 1024];
        if (tid == 0 && !(fabsf(got - ref) <= 0.03f + 0.03f * fabsf(ref))) dbg_flag(p, 10u);
    }
}

__global__ void dbg_scan_bf16(P p, size_t off, size_t n, float bound, unsigned id) {
    const bf16_t* q = (const bf16_t*)(p.ws + off); bool bad = false;
    for (size_t i = (size_t)blockIdx.x * blockDim.x + threadIdx.x; i < n; i += (size_t)gridDim.x * blockDim.x) { const float v = bf2f(q[i]); if (!(fabsf(v) <= bound)) bad = true; }
    if (bad) atomicMax((unsigned*)p.ws, id);
}
__global__ void dbg_scan_f32(P p, const float* q, size_t n, float lo, float hi, unsigned id) {
    bool bad = false;
    for (size_t i = (size_t)blockIdx.x * blockDim.x + threadIdx.x; i < n; i += (size_t)gridDim.x * blockDim.x) { const float v = q[i]; if (!(v >= lo && v <= hi)) bad = true; }
    if (bad) atomicMax((unsigned*)p.ws, id);
}
__global__ void dbg_scan_gp(P p, int suboff, int sublen, float bound, unsigned id) {
    bool bad = false;
    for (int item = blockIdx.x; item < 1024; item += gridDim.x) { const bf16_t* q = (const bf16_t*)(p.ws + WS_GP) + (size_t)item * 36864 + suboff;
        for (int i = threadIdx.x; i < sublen; i += blockDim.x) { const float v = bf2f(q[i]); if (!(fabsf(v) <= bound)) bad = true; } }
    if (bad) atomicMax((unsigned*)p.ws, id);
}
__global__ void dbg_scan2(P p, size_t base, size_t stride, int sublen, float bound, unsigned id_nan, unsigned id_big) {
    bool nan = false, big = false;
    for (int item = blockIdx.x; item < 1024; item += gridDim.x) { const bf16_t* q = (const bf16_t*)(p.ws + base) + (size_t)item * stride;
        for (int i = threadIdx.x; i < sublen; i += blockDim.x) { const float v = bf2f(q[i]); if (v != v) nan = true; else if (fabsf(v) > bound) big = true; } }
    if (nan) atomicMax((unsigned*)p.ws, id_nan); if (big) atomicMax((unsigned*)p.ws, id_big);
}
__global__ void dbg_scanbit(P p, size_t base, size_t stride, int sublen, float bound, unsigned bit) {
    bool bad = false;
    for (int item = blockIdx.x; item < 1024; item += gridDim.x) { const bf16_t* q = (const bf16_t*)(p.ws + base) + (size_t)item * stride;
        for (int i = threadIdx.x; i < sublen; i += blockDim.x) { const float v = bf2f(q[i]); if (!(fabsf(v) <= bound)) bad = true; } }
    if (bad) atomicOr((unsigned*)p.ws + 1, 1u << bit);
}
__global__ void dbg_report(P p) { const unsigned f = *(const unsigned*)p.ws, m = ((const unsigned*)p.ws)[1]; if (m) p.out[O_Y] = 1000.f * (float)(10u + m); else if (f) p.out[O_Y] = 1000.f * (float)f; }

__global__ void __launch_bounds__(NTHR, 2) mega(P p) {
    extern __shared__ __attribute__((aligned(16))) unsigned char lds_raw[];
    LAS unsigned char* lds = (LAS unsigned char*)lds_raw;
    cg::grid_group grid = cg::this_grid();
    const int G = gridDim.x, bid = blockIdx.x, tid = threadIdx.x;
    unsigned char* ws = p.ws;
#define PH(k) (p.ph_lo <= (k) && (k) < p.ph_hi)
#define SEAM(k) do { if (PH(k) && PH((k) + 1)) grid.sync(); } while (0)

    if (PH(0)) phase0(lds, p, bid, G);
    SEAM(0);

    if (PH(1)) {
        { pg8::Gemm g{(const bf16_t*)(ws + WS_XN), (const bf16_t*)(ws + WS_WIN), 9216, NPROJ, 2048, 0}; pg8::StaticOrder S; S.init(9216, NPROJ, G, bid);
          pg8::EpiProj E{(bf16_t*)(ws + WS_PROJ), (float*)(ws + WS_GBA)}; if (EN_GEMM) pg8::gemm_phase(lds, g, S, E); }
        { pg8::Gemm g{(const bf16_t*)(ws + WS_MEMN), (const bf16_t*)(ws + WS_WMKV), 1024, 2048, 2048, 0}; pg8::StaticOrder S; S.init(1024, 2048, G, G - 1 - bid);
          pg8::EpiMemKV E{p.out + O_MK, p.out + O_MV, (bf16_t*)(ws + WS_MKB), (bf16_t*)(ws + WS_MVB)}; if (EN_GEMM) pg8::gemm_phase(lds, g, S, E); }
    }
    SEAM(1);

    if (PH(2)) {
        for (int it = bid; it < 1024 + 512; it += G) {
            if (it < 1024) { if (EN_PREP) gdn_prep_item(lds, p, it); }
            else { const int k = it - 1024, b = k >> 2, h = k & 3;
                if (EN_ATTS) attn_item<true>(lds, (const bf16_t*)(ws + WS_PROJ) + (size_t)(8192 + b * 8) * NPROJ + C_MQ + h * 256, 8,
                                p.in[3] + (size_t)b * 262144 + h * 256, p.in[4] + (size_t)b * 262144 + h * 256,
                                (bf16_t*)(ws + WS_YCAT) + (size_t)2 * 9216 * 1024 + (size_t)(8192 + b * 8) * 1024 + h * 256); }
        }
        conv_states(p, bid, G);
    }
    SEAM(2);

    if (PH(3)) {
        const int NMISC = 256 + 512 + 256;
        if (bid < 32) { if (EN_SEQ && (p.roles & 1)) gdn_seq_item(lds, p, bid); } else if (bid < 160) { if (EN_RGP && (p.roles & 2)) rglru_item<true>(lds, p, bid - 32); }
        if (bid >= 160) {
            int tb = 0; const int b2 = bid - 160, g2 = G - 160;
            tconv(lds, p.in[24], 1024, 2048, (bf16_t*)(ws + WS_WUPS), 2048, nullptr, false, tb, b2, g2);
            tconv(lds, p.in[25], 1024, 2048, (bf16_t*)(ws + WS_WUPS) + (size_t)2048 * 1024, 2048, nullptr, false, tb, b2, g2);
            tconv(lds, p.in[26], 1024, 2048, (bf16_t*)(ws + WS_WUPS) + (size_t)2 * 2048 * 1024, 2048, nullptr, false, tb, b2, g2);
            tconv(lds, p.in[27], 2048, 2048, (bf16_t*)(ws + WS_WOUT), 2048, nullptr, false, tb, b2, g2);
            tconv(lds, p.in[29], 2048, 8192, (bf16_t*)(ws + WS_WUP), 8192, p.in[28], false, tb, b2, g2);
            tconv(lds, p.in[30], 8192, 2048, (bf16_t*)(ws + WS_WDN), 2048, nullptr, false, tb, b2, g2);
        }
        if (p.roles & 4) {
            LAS int* slot = (LAS int*)(lds + 137216);
            for (;;) {
                __syncthreads();
                if (tid == 0) *slot = (int)atomicAdd((unsigned*)ws + 16, 1u);
                __syncthreads();
                const int it = *slot;
                if (it >= NMISC) break;
                if (it < 256) { const int b = it >> 6, h = (it >> 4) & 3, t = it & 15; const size_t row0 = (size_t)b * 2048 + t * 128;
                    if (EN_ATTP) attn_item<false>(lds, (const bf16_t*)(ws + WS_PROJ) + row0 * NPROJ + C_MQ + h * 256, 128,
                                     (const bf16_t*)(ws + WS_MKB) + (size_t)b * 262144 + h * 256, (const bf16_t*)(ws + WS_MVB) + (size_t)b * 262144 + h * 256,
                                     (bf16_t*)(ws + WS_YCAT) + (size_t)2 * 9216 * 1024 + row0 * 1024 + h * 256); }
                else if (it < 768) { if (EN_GS) gdn_sample_pass(lds, p, it - 256); }
                else { if (EN_RGS) rglru_item<false>(lds, p, it - 768); }
            }
        }
    }
    SEAM(3);

    if (PH(4)) {
        pg8::Gemm g{(const bf16_t*)(ws + WS_YCAT), (const bf16_t*)(ws + WS_WUPS), 3 * 9216, 3 * 2048, 1024, 0}; pg8::TripleOrder S{G, bid};
        pg8::EpiMerge E{(const bf16_t*)(ws + WS_PROJ), (float*)(ws + WS_GP), (bf16_t*)(ws + WS_MERGED)}; if (EN_GEMM) pg8::gemm_phase(lds, g, S, E);
    }
    SEAM(4);

    if (PH(5)) {
        pg8::Gemm g{(const bf16_t*)(ws + WS_MERGED), (const bf16_t*)(ws + WS_WOUT), 9216, 2048, 2048, 0}; pg8::StaticOrder S; S.init(9216, 2048, G, bid);
        pg8::EpiOut E{p.in[0], p.in[1], p.out + O_Y, (bf16_t*)(ws + WS_XN), (float*)(ws + WS_SS1)}; if (EN_GEMM) pg8::gemm_phase(lds, g, S, E);
    }
    SEAM(5);

    if (PH(6)) {
        pg8::Gemm g{(const bf16_t*)(ws + WS_XN), (const bf16_t*)(ws + WS_WUP), 9216, 8192, 2048, 0}; pg8::StaticOrder S; S.init(9216, 8192, G, bid);
        pg8::EpiUp E{(const float*)(ws + WS_SS1), (bf16_t*)(ws + WS_PROJ)}; if (EN_GEMM) pg8::gemm_phase(lds, g, S, E);
    }
    SEAM(6);

    if (PH(7)) {
        { pg8::Gemm g{(const bf16_t*)(ws + WS_PROJ), (const bf16_t*)(ws + WS_WDN), 9216, 2048, 8192, 0}; pg8::DownMain S{G, bid};
          pg8::EpiDown E{p.out + O_Y, (const bf16_t*)(ws + WS_XN)}; if (EN_GEMM) pg8::gemm_phase(lds, g, S, E); }
        { pg8::Gemm g{(const bf16_t*)(ws + WS_PROJ), (const bf16_t*)(ws + WS_WDN), 9216, 2048, 8192, 16}; pg8::DownTail S{G, bid};
          pg8::EpiDownPart E{(float*)(ws + WS_GP)}; if (EN_GEMM) pg8::gemm_phase(lds, g, S, E); }
    }
    SEAM(7);

    if (PH(8)) {
        const int lane = tid & 63, wid = tid >> 6; const float* part = (const float*)(ws + WS_GP);
        for (int row = bid * 8 + wid; row < 9216; row += G * 8) { float* x = p.out + O_Y + (size_t)row * 2048; f32x4 v[8]; float ss = 0.f;
            if (row < 8192) {
#pragma unroll
                for (int i = 0; i < 8; ++i) { const int c = (i * 64 + lane) * 4; v[i] = *(const f32x4*)(x + c); }
            } else { const bf16_t* xb = (const bf16_t*)(ws + WS_XN) + (size_t)row * 2048;
#pragma unroll
                for (int i = 0; i < 8; ++i) { const u32x2 r = *(const u32x2*)(xb + (i * 64 + lane) * 4); v[i] = (f32x4){bf_lo(r.x), bf_hi(r.x), bf_lo(r.y), bf_hi(r.y)}; }
#pragma unroll 1
                for (int sl = 0; sl < 8; ++sl) { const float* pr = part + ((size_t)sl * 1024 + (row - 8192)) * 2048;
#pragma unroll
                    for (int i = 0; i < 8; ++i) v[i] += *(const f32x4*)(pr + (i * 64 + lane) * 4); } }
#pragma unroll
            for (int i = 0; i < 8; ++i) ss += v[i][0] * v[i][0] + v[i][1] * v[i][1] + v[i][2] * v[i][2] + v[i][3] * v[i][3];
#pragma unroll
            for (int o = 32; o >= 1; o >>= 1) ss += __shfl_xor(ss, o);
            const float rs = rsqrtf(ss * (1.f / 2048.f) + 1e-6f);
#pragma unroll
            for (int i = 0; i < 8; ++i) { const int c = (i * 64 + lane) * 4; *(f32x4*)(x + c) = v[i] * rs * *(const f32x4*)(p.in[31] + c); } }
    }
#undef PH
#undef SEAM
}

extern "C" void kernel_launch(void* const* d_in, const int* in_sizes, int n_in, void* d_out, int out_size, void* d_ws, size_t ws_size, hipStream_t stream) {
    static int grid = 0;
    if (grid == 0) {
        if (n_in != 32 || out_size != 40030208 || ws_size < WS_END) { fprintf(stderr, "kernel_launch: unexpected shapes (n_in %d, out %d, ws %zu; need ws >= %zu)\n", n_in, out_size, ws_size, (size_t)WS_END); grid = -1; return; }
        int dev = 0, cus = 0, per_cu = 0;
        hipGetDevice(&dev); hipDeviceGetAttribute(&cus, hipDeviceAttributeMultiprocessorCount, dev);
        if (hipFuncSetAttribute((const void*)mega, hipFuncAttributeMaxDynamicSharedMemorySize, LDS_BYTES) != hipSuccess) { fprintf(stderr, "kernel_launch: hipFuncSetAttribute failed\n"); grid = -1; return; }
        if (hipOccupancyMaxActiveBlocksPerMultiprocessor(&per_cu, (const void*)mega, NTHR, LDS_BYTES) != hipSuccess || per_cu < 1) { fprintf(stderr, "kernel_launch: occupancy query says %d\n", per_cu); (void)hipGetLastError(); per_cu = 1; }
        grid = cus * 1;
        if (grid < 192) { fprintf(stderr, "kernel_launch: needs >= 192 CUs (got %d)\n", grid); grid = -1; return; }
    }
    if (grid < 0) return;
    P p{};
    for (int i = 0; i < 32; ++i) p.in[i] = (const float*)d_in[i];
    p.out = (float*)d_out; p.ws = (unsigned char*)d_ws; p.roles = 7;
#if defined(PROBE_SEGS)
    { static const int segs[][2] = PROBE_SEGS; const int nseg = (int)(sizeof(segs) / sizeof(segs[0]));
      for (int si = 0; si < nseg; ++si) { P q = p; q.ph_lo = segs[si][0]; q.ph_hi = segs[si][1]; if (si == 1) q.roles = PROBE_ROLES; void* qa[] = {&q};
          if (q.ph_hi - q.ph_lo > 1) (void)hipLaunchCooperativeKernel((const void*)mega, dim3(grid), dim3(NTHR), qa, LDS_BYTES, stream);
          else hipLaunchKernelGGL(mega, dim3(grid), dim3(NTHR), LDS_BYTES, stream, q); } }
#elif ONE_LAUNCH
    p.ph_lo = 0; p.ph_hi = DBG_PH_HI;
    void* args[] = {&p};
    hipError_t e = hipLaunchCooperativeKernel((const void*)mega, dim3(grid), dim3(NTHR), args, LDS_BYTES, stream);
    if (e != hipSuccess) fprintf(stderr, "cooperative launch failed: %s (grid %d)\n", hipGetErrorString(e), grid);
#else
    (void)hipMemsetAsync(d_ws, 0, 256, stream);
    for (int k = 0; k < DBG_PH_HI; ++k) { p.ph_lo = k; p.ph_hi = k + 1; hipLaunchKernelGGL(mega, dim3(grid), dim3(NTHR), LDS_BYTES, stream, p);
        if (k == 1) hipLaunchKernelGGL(dbg_check_gemm1, dim3(256), dim3(NTHR), 0, stream, p);
        if (k == 2) { hipLaunchKernelGGL(dbg_scan_f32, dim3(4), dim3(256), 0, stream, p, (const float*)((unsigned char*)d_ws + WS_DEC), (size_t)1024, 0.f, 1.f, 21u);
            hipLaunchKernelGGL(dbg_scanbit, dim3(256), dim3(256), 0, stream, p, (size_t)WS_GP, (size_t)36864, 8192, 100.f, 0u);
            hipLaunchKernelGGL(dbg_scanbit, dim3(256), dim3(256), 0, stream, p, (size_t)WS_GP + 16384 * 2, (size_t)36864, 8192, 100.f, 1u); }
    }
    hipLaunchKernelGGL(dbg_report, dim3(1), dim3(1), 0, stream, p);
#endif
}
```

```cpp
#include <hip/hip_runtime.h>
#include <hip/hip_cooperative_groups.h>
#include <cstdio>
namespace cg = cooperative_groups;

#ifndef ONE_LAUNCH
#define ONE_LAUNCH 1
#endif
#ifndef DBG_DUMP
#define DBG_DUMP 0
#endif
#ifndef DBG_SEQ_SUM
#define DBG_SEQ_SUM 0
#endif
#ifndef DBG_PH_HI
#define DBG_PH_HI 9
#endif


#ifndef EN_ALL
#define EN_ALL 1
#endif
#ifndef EN_PREP
#define EN_PREP EN_ALL
#endif
#ifndef EN_ATTS
#define EN_ATTS EN_ALL
#endif
#ifndef EN_SEQ
#define EN_SEQ EN_ALL
#endif
#ifndef EN_RGP
#define EN_RGP EN_ALL
#endif
#ifndef EN_ATTP
#define EN_ATTP EN_ALL
#endif
#ifndef EN_GS
#define EN_GS EN_ALL
#endif
#ifndef EN_RGS
#define EN_RGS EN_ALL
#endif
#ifndef EN_GEMM
#define EN_GEMM EN_ALL
#endif
#define LAS __attribute__((address_space(3)))
typedef unsigned short bf16_t;
typedef short bf16x8 __attribute__((ext_vector_type(8)));
typedef short s16x4 __attribute__((ext_vector_type(4)));
typedef float f32x4 __attribute__((ext_vector_type(4)));
typedef unsigned u32x4 __attribute__((ext_vector_type(4)));
typedef unsigned u32x2 __attribute__((ext_vector_type(2)));

constexpr int NPROJ = 13568;
constexpr int C_RX = 0, C_RG = 1024, C_GQ = 2048, C_GZ = 5120, C_MQ = 6144, C_MG = 7168;
constexpr int NTHR = 512;
constexpr int LDS_BYTES = 137280;
constexpr int NPHASE = 9;

constexpr size_t O_Y = 0, O_MK = 18874368, O_MV = 19922944, O_RCP = 20971520, O_RHP = 20983808, O_GCP = 20987904, O_GSP = 21024768,
                 O_RCS = 21549056, O_RHS = 21942272, O_GCS = 22073344, O_GSS = 23252992;
constexpr size_t WS_SS1 = 4096, WS_SS2 = 40960, WS_DEC = 77824, WS_GBA = 81920, WS_WIN = 1048576, WS_WMKV = 56623104, WS_WUPS = 65011712,
                 WS_WOUT = 77594624, WS_WUP = 85983232, WS_WDN = 119537664, WS_WRG = 153092096, WS_XN = 153616384, WS_MEMN = 191365120,
                 WS_MKB = 195559424, WS_MVB = 197656576, WS_YCAT = 199753728, WS_MERGED = 256376832, WS_GP = 294125568, WS_PROJ = 369623040,
                 WS_END = 619708416;

struct P { const float* in[32]; float* out; unsigned char* ws; int ph_lo, ph_hi, roles, pad; };

typedef __bf16 bf16v2_t __attribute__((ext_vector_type(2)));
typedef float f32v2_t __attribute__((ext_vector_type(2)));
__device__ __forceinline__ unsigned cvt_pk_bf16(float lo, float hi) { const f32v2_t v = {lo, hi}; const bf16v2_t b = __builtin_convertvector(v, bf16v2_t); return __builtin_bit_cast(unsigned, b); }
__device__ __forceinline__ bf16_t f2bf(float f) { return (bf16_t)(cvt_pk_bf16(f, 0.f) & 0xffffu); }
__device__ __forceinline__ float bf2f(bf16_t b) { return __uint_as_float(((unsigned)b) << 16); }
__device__ __forceinline__ float bf_lo(unsigned u) { return __uint_as_float(u << 16); }
__device__ __forceinline__ float bf_hi(unsigned u) { return __uint_as_float(u & 0xffff0000u); }
__device__ __forceinline__ float sigm(float x) { return __builtin_amdgcn_rcpf(1.f + __expf(-x)); }
__device__ __forceinline__ float siluf(float x) { return x * sigm(x); }
__device__ __forceinline__ float softplusf(float x) { return fmaxf(x, 0.f) + log1pf(__expf(-fabsf(x))); }
__device__ __forceinline__ float actf(float x, int act) {
    if (act == 1) { const float t = 1.5957691216f * (x + 0.044715f * x * x * x); return x * sigm(t); }
    if (act == 2) return x * sigm(x);
    return sigm(x);
}
__device__ __forceinline__ float DBGFIN(float x) { return x; }
#define LDS_BAR() do { asm volatile("s_waitcnt lgkmcnt(0)" ::: "memory"); __builtin_amdgcn_s_barrier(); asm volatile("" ::: "memory"); } while (0)
#define MFMA16(a, b, c) __builtin_amdgcn_mfma_f32_16x16x32_bf16((a), (b), (c), 0, 0, 0)

namespace pg8 {
constexpr int BM = 256, BK = 64, HALF = 128, HTB = HALF * BK * 2, STAGE_BYTES = 8 * HTB, NXCD = 8, WGM = 8;
__host__ __device__ __forceinline__ int lds_byte(int r, int c) { const int st = (r >> 4) * 2 + (c >> 5), rr = r & 15, cc = c & 31, ob = rr * 64 + cc * 2; return st * 1024 + (ob ^ (((ob >> 9) & 1) << 5)); }
__host__ __device__ __forceinline__ void stage_rc(int b, int& R, int& C) { const int st = b / 1024, sb = b % 1024, swz = sb ^ (((sb >> 9) & 1) << 5); R = (st >> 1) * 16 + swz / 64; C = (st & 1) * 32 + (swz % 64) / 2; }
__host__ __device__ __forceinline__ int perm32(int rho) { const int n = rho >> 4, i = rho & 15; return 8 * (i >> 2) + 4 * n + (i & 3); }
struct Unit { int pm, pn, k0; };
struct Gemm { const bf16_t* A; const bf16_t* Bt; int M, N, K; int ntu; };
struct StaticOrder {
    int nM, nN, nwg, G, c;
    __device__ void init(int M, int N, int G_, int c_) { nM = M / BM; nN = N / BM; nwg = nM * nN; G = G_; c = c_; }
    __device__ bool next(int i, Unit& u) const {
        const long L = (long)i * G + c; if (L >= nwg) return false;
        int wgid = (int)L; { const int q = nwg / NXCD, r = nwg % NXCD, xcd = wgid % NXCD, off = wgid / NXCD; wgid = (xcd < r ? xcd * (q + 1) : r * (q + 1) + (xcd - r) * q) + off; }
        const int nig = WGM * nN, gid = wgid / nig, fm = gid * WGM, gsz = (nM - fm) < WGM ? (nM - fm) : WGM;
        u.pm = fm + ((wgid % nig) % gsz); u.pn = (wgid % nig) / gsz; u.k0 = 0; return true;
    }
};
struct TripleOrder {
    int G, c;
    __device__ bool next(int i, Unit& u) const {
        StaticOrder S0; S0.init(9216, 2048, G, c); Unit t; if (!S0.next(i / 3, t)) return false;
        const int br = i % 3; u.pm = br * 36 + t.pm; u.pn = br * 8 + t.pn; u.k0 = 0; return true;
    }
};

struct DownMain { int G, c; __device__ bool next(int i, Unit& u) const { const int L = i * G + c; if (L >= 256) return false; const int x = L & 7, j = L >> 3;
        u.pm = (x >> 1) * 8 + (j & 7); u.pn = (x & 1) * 4 + (j >> 3); u.k0 = 0; return true; } };
struct DownTail { int G, c; __device__ bool next(int i, Unit& u) const { const int L = i * G + c; if (L >= 256) return false; const int t = L >> 3; u.pm = 32 + (t >> 3); u.pn = t & 7; u.k0 = (L & 7) * 16; return true; } };

template <class Epi, class Sched>
__device__ __forceinline__ void gemm_phase(LAS unsigned char* lds, const Gemm g, const Sched& S, const Epi& E) {
    const int tid = threadIdx.x, wid = __builtin_amdgcn_readfirstlane(tid >> 6), lane = tid & 63, wr = wid >> 2, wc = wid & 3, fr = lane & 15, fq = lane >> 4;
    const int K = g.K, nt = g.ntu ? g.ntu : K / BK;
    unsigned voffA[2], voffB[2];
#pragma unroll
    for (int i = 0; i < 2; ++i) { int R, C; stage_rc(tid * 16 + i * 8192, R, C); const int Rb = Epi::PERM ? ((R & ~31) + perm32(R & 31)) : R;
        voffA[i] = (unsigned)(R * K + C) * 2u; voffB[i] = (unsigned)(Rb * K + C) * 2u; }
    const size_t kstep = (size_t)(BK * 2);
    const size_t hstep = (size_t)HALF * K * 2;
    const size_t tstep = 2 * hstep;
    const unsigned ldsw = (unsigned)wid * 1024u;
    const int aoff = lds_byte(wr * 64 + fr, fq * 8), boff = lds_byte(wc * 32 + fr, fq * 8);
#define PG8_SA(b, h) (((b) * 2 + (h)) * HTB)
#define PG8_SB(b, h) ((4 + (b) * 2 + (h)) * HTB)
#define PG8_STAGE(bufoff, gbase, voff) do { _Pragma("unroll") for (int _i = 0; _i < 2; ++_i) \
        __builtin_amdgcn_global_load_lds((const unsigned*)((const char*)(gbase) + (voff)[_i]), (LAS unsigned*)(lds + (bufoff) + ldsw + _i * 8192), 16, 0, 0); } while (0)
#define PG8_LDA(dst, b, h) do { _Pragma("unroll") for (int m = 0; m < 4; ++m) _Pragma("unroll") for (int k = 0; k < 2; ++k) dst[m][k] = *(const LAS bf16x8*)(lds + PG8_SA(b, h) + aoff + m * 2048 + k * 1024); } while (0)
#define PG8_LDB(dst, b, h) do { _Pragma("unroll") for (int n = 0; n < 2; ++n) _Pragma("unroll") for (int k = 0; k < 2; ++k) dst[n][k] = *(const LAS bf16x8*)(lds + PG8_SB(b, h) + boff + n * 2048 + k * 1024); } while (0)
#define PG8_MMA(ai, bj, At, Bt) do { __builtin_amdgcn_s_setprio(1); _Pragma("unroll") for (int m = 0; m < 4; ++m) _Pragma("unroll") for (int n = 0; n < 2; ++n) _Pragma("unroll") for (int k = 0; k < 2; ++k) \
        acc[ai][bj][m][n] = __builtin_amdgcn_mfma_f32_16x16x32_bf16(Bt[n][k], At[m][k], acc[ai][bj][m][n], 0, 0, 0); __builtin_amdgcn_s_setprio(0); } while (0)
#define PG8_WAIT_V(n) asm volatile("s_waitcnt vmcnt(" #n ")" ::: "memory")
#define PG8_WAIT_L(n) asm volatile("s_waitcnt lgkmcnt(" #n ")" ::: "memory")
#define PG8_BAR __builtin_amdgcn_s_barrier()
#define PG8_SCHED __builtin_amdgcn_sched_barrier(0)
    Unit cur, nxt; int ui = 0;
    if (!S.next(0, cur)) return;
    f32x4 acc[2][2][4][2];
#pragma unroll
    for (int a = 0; a < 2; ++a)
#pragma unroll
        for (int b = 0; b < 2; ++b)
#pragma unroll
            for (int m = 0; m < 4; ++m)
#pragma unroll
                for (int n = 0; n < 2; ++n) acc[a][b][m][n] = (f32x4){0.f, 0.f, 0.f, 0.f};
    bf16x8 At[4][2], B0[2][2], B1[2][2];
    const char* cA = (const char*)g.A + (size_t)cur.pm * tstep + (size_t)cur.k0 * (BK * 2); const char* cB = (const char*)g.Bt + (size_t)cur.pn * tstep + (size_t)cur.k0 * (BK * 2);
    PG8_STAGE(PG8_SB(0, 0), cB, voffB); PG8_STAGE(PG8_SA(0, 0), cA, voffA); PG8_STAGE(PG8_SB(0, 1), cB + hstep, voffB); PG8_STAGE(PG8_SA(0, 1), cA + hstep, voffA);
    if (wr == 1) PG8_BAR;
    PG8_WAIT_V(4); PG8_BAR;
    PG8_STAGE(PG8_SB(1, 0), cB + kstep, voffB); PG8_STAGE(PG8_SA(1, 0), cA + kstep, voffA); PG8_STAGE(PG8_SB(1, 1), cB + hstep + kstep, voffB);
    PG8_WAIT_V(6); PG8_BAR;
    for (;;) {
        const bool has_next = S.next(ui + 1, nxt);
        const char* nA = has_next ? (const char*)g.A + (size_t)nxt.pm * tstep + (size_t)nxt.k0 * (BK * 2) : cA; const char* nB = has_next ? (const char*)g.Bt + (size_t)nxt.pn * tstep + (size_t)nxt.k0 * (BK * 2) : cB;
        for (int t = 0; t < nt; t += 2) {
            const bool last = (t == nt - 2);
            const char* a1 = cA + (size_t)(t + 1) * kstep;
            const char* a2 = last ? nA : cA + (size_t)(t + 2) * kstep; const char* b2 = last ? nB : cB + (size_t)(t + 2) * kstep;
            const char* a3 = a2 + kstep; const char* b3 = b2 + kstep;
            PG8_LDB(B0, 0, 0); PG8_SCHED; PG8_LDA(At, 0, 0); PG8_STAGE(PG8_SA(1, 1), a1 + hstep, voffA);
            PG8_WAIT_L(8); PG8_BAR; PG8_WAIT_L(0); PG8_MMA(0, 0, At, B0); PG8_BAR; PG8_SCHED;
            PG8_LDB(B1, 0, 1); PG8_STAGE(PG8_SB(0, 0), b2, voffB);
            PG8_BAR; PG8_WAIT_L(0); PG8_MMA(0, 1, At, B1); PG8_BAR;
            PG8_LDA(At, 0, 1); PG8_STAGE(PG8_SA(0, 0), a2, voffA);
            PG8_BAR; PG8_WAIT_L(0); PG8_MMA(1, 0, At, B0); PG8_BAR; PG8_SCHED;
            PG8_STAGE(PG8_SB(0, 1), b2 + hstep, voffB);
            PG8_WAIT_V(6); PG8_BAR; PG8_MMA(1, 1, At, B1); PG8_BAR;
            PG8_LDB(B0, 1, 0); PG8_SCHED; PG8_LDA(At, 1, 0); PG8_STAGE(PG8_SA(0, 1), a2 + hstep, voffA);
            PG8_WAIT_L(8); PG8_BAR; PG8_WAIT_L(0); PG8_MMA(0, 0, At, B0); PG8_BAR; PG8_SCHED;
            PG8_LDB(B1, 1, 1); PG8_STAGE(PG8_SB(1, 0), b3, voffB);
            PG8_BAR; PG8_WAIT_L(0); PG8_MMA(0, 1, At, B1); PG8_BAR;
            PG8_LDA(At, 1, 1); PG8_STAGE(PG8_SA(1, 0), a3, voffA);
            PG8_BAR; PG8_WAIT_L(0); PG8_MMA(1, 0, At, B0); PG8_BAR; PG8_SCHED;
            PG8_STAGE(PG8_SB(1, 1), b3 + hstep, voffB);
            PG8_WAIT_V(6); PG8_BAR; PG8_MMA(1, 1, At, B1); PG8_BAR;
        }
        E(acc, cur, wr, wc, fr, fq);
        if (!has_next) break;
#pragma unroll
        for (int a = 0; a < 2; ++a)
#pragma unroll
            for (int b = 0; b < 2; ++b)
#pragma unroll
                for (int m = 0; m < 4; ++m)
#pragma unroll
                    for (int n = 0; n < 2; ++n) acc[a][b][m][n] = (f32x4){0.f, 0.f, 0.f, 0.f};
        cur = nxt; cA = nA; cB = nB; ++ui;
    }
    PG8_WAIT_V(0);
    if (wr == 0) PG8_BAR;
    PG8_BAR;
#undef PG8_SA
#undef PG8_SB
#undef PG8_STAGE
#undef PG8_LDA
#undef PG8_LDB
#undef PG8_MMA
#undef PG8_WAIT_V
#undef PG8_WAIT_L
#undef PG8_BAR
#undef PG8_SCHED
}

typedef f32x4 Acc[2][2][4][2];

struct EpiProj {
    static constexpr bool PERM = true;
    bf16_t* O; float* gba;
    __device__ __forceinline__ void operator()(const Acc& acc, const Unit& u, int wr, int wc, int fr, int fq) const {
        const int row0 = u.pm * BM + wr * 64 + fr, col0 = u.pn * BM + wc * 32 + 8 * fq;
        const int pn = u.pn; const int act = (pn >= 4 && pn < 8) ? 1 : (pn >= 20 && pn < 24) ? 2 : (pn >= 28 && pn < 52) ? 3 : 0;
#pragma unroll
        for (int ai = 0; ai < 2; ++ai)
#pragma unroll
            for (int m = 0; m < 4; ++m) { bf16_t* rowp = O + (size_t)(row0 + ai * HALF + m * 16) * NPROJ + col0;
#pragma unroll
                for (int bj = 0; bj < 2; ++bj) { f32x4 v0 = acc[ai][bj][m][0], v1 = acc[ai][bj][m][1];
                    if (act) {
#pragma unroll
                        for (int j = 0; j < 4; ++j) { v0[j] = actf(v0[j], act); v1[j] = actf(v1[j], act); } }
                    u32x4 w; w.x = cvt_pk_bf16(v0[0], v0[1]); w.y = cvt_pk_bf16(v0[2], v0[3]); w.z = cvt_pk_bf16(v1[0], v1[1]); w.w = cvt_pk_bf16(v1[2], v1[3]);
                    *(u32x4*)(rowp + bj * HALF) = w; } }
        if (pn == 52 && wc == 0 && fq < 2) {
#pragma unroll
            for (int ai = 0; ai < 2; ++ai)
#pragma unroll
                for (int m = 0; m < 4; ++m) { float* gp = gba + (size_t)(row0 + ai * HALF + m * 16) * 16 + 8 * fq;
                    *(f32x4*)gp = acc[ai][0][m][0]; *(f32x4*)(gp + 4) = acc[ai][0][m][1]; } }
    }
};
struct EpiMemKV {
    static constexpr bool PERM = true;
    float* outk; float* outv; bf16_t* kb; bf16_t* vb;
    __device__ __forceinline__ void operator()(const Acc& acc, const Unit& u, int wr, int wc, int fr, int fq) const {
        const int row0 = u.pm * BM + wr * 64 + fr; const bool isv = u.pn >= 4; const int col0 = (u.pn & 3) * BM + wc * 32 + 8 * fq;
        float* of = isv ? outv : outk; bf16_t* ob = isv ? vb : kb;
#pragma unroll
        for (int ai = 0; ai < 2; ++ai)
#pragma unroll
            for (int m = 0; m < 4; ++m) { const size_t ro = (size_t)(row0 + ai * HALF + m * 16) * 1024 + col0;
#pragma unroll
                for (int bj = 0; bj < 2; ++bj) { const f32x4 v0 = acc[ai][bj][m][0], v1 = acc[ai][bj][m][1];
                    *(f32x4*)(of + ro + bj * HALF) = v0; *(f32x4*)(of + ro + bj * HALF + 4) = v1;
                    u32x4 w; w.x = cvt_pk_bf16(v0[0], v0[1]); w.y = cvt_pk_bf16(v0[2], v0[3]); w.z = cvt_pk_bf16(v1[0], v1[1]); w.w = cvt_pk_bf16(v1[2], v1[3]);
                    *(u32x4*)(ob + ro + bj * HALF) = w; } }
    }
};
struct EpiMerge {
    static constexpr bool PERM = true;
    const bf16_t* proj; float* mf; bf16_t* merged;
    __device__ __forceinline__ void operator()(const Acc& acc, const Unit& u, int wr, int wc, int fr, int fq) const {
        const int br = u.pm / 36, pm = u.pm - br * 36, pn = u.pn & 7;
        const int row0 = pm * BM + wr * 64 + fr, col0 = pn * BM + wc * 32 + 8 * fq;
#pragma unroll
        for (int ai = 0; ai < 2; ++ai)
#pragma unroll
            for (int m = 0; m < 4; ++m) { const size_t row = (size_t)(row0 + ai * HALF + m * 16);
#pragma unroll
                for (int bj = 0; bj < 2; ++bj) { const int col = col0 + bj * HALF;
                    const u32x4 gw = *(const u32x4*)(proj + row * NPROJ + C_MG + br * 2048 + col);
                    f32x4 v0 = acc[ai][bj][m][0], v1 = acc[ai][bj][m][1];
                    v0[0] *= bf_lo(gw.x); v0[1] *= bf_hi(gw.x); v0[2] *= bf_lo(gw.y); v0[3] *= bf_hi(gw.y);
                    v1[0] *= bf_lo(gw.z); v1[1] *= bf_hi(gw.z); v1[2] *= bf_lo(gw.w); v1[3] *= bf_hi(gw.w);
                    bf16_t* mp = merged + row * 2048 + col;
                    if (br > 0) { const u32x4 pv = *(const u32x4*)mp; v0[0] += bf_lo(pv.x); v0[1] += bf_hi(pv.x); v0[2] += bf_lo(pv.y); v0[3] += bf_hi(pv.y);
                        v1[0] += bf_lo(pv.z); v1[1] += bf_hi(pv.z); v1[2] += bf_lo(pv.w); v1[3] += bf_hi(pv.w); }
                    { u32x4 w; w.x = cvt_pk_bf16(v0[0], v0[1]); w.y = cvt_pk_bf16(v0[2], v0[3]); w.z = cvt_pk_bf16(v1[0], v1[1]); w.w = cvt_pk_bf16(v1[2], v1[3]);
                        *(u32x4*)mp = w; } }
                asm volatile("" ::: "memory"); }
    }
};
struct EpiOut {
    static constexpr bool PERM = true;
    const float* xp; const float* xs; float* x1; bf16_t* x1b; float* ss;
    __device__ __forceinline__ void operator()(const Acc& acc, const Unit& u, int wr, int wc, int fr, int fq) const {
        const int row0 = u.pm * BM + wr * 64 + fr, col0 = u.pn * BM + wc * 32 + 8 * fq;
        const float* xb = (u.pm < 32) ? xp : xs - (size_t)8192 * 2048;
#pragma unroll
        for (int ai = 0; ai < 2; ++ai)
#pragma unroll
            for (int m = 0; m < 4; ++m) { const size_t row = (size_t)(row0 + ai * HALF + m * 16); float s = 0.f;
#pragma unroll
                for (int bj = 0; bj < 2; ++bj) { const size_t o = row * 2048 + col0 + bj * HALF;
                    const f32x4 v0 = acc[ai][bj][m][0] + *(const f32x4*)(xb + o), v1 = acc[ai][bj][m][1] + *(const f32x4*)(xb + o + 4);
                    s += v0[0] * v0[0] + v0[1] * v0[1] + v0[2] * v0[2] + v0[3] * v0[3] + v1[0] * v1[0] + v1[1] * v1[1] + v1[2] * v1[2] + v1[3] * v1[3];
                    u32x4 w; w.x = cvt_pk_bf16(v0[0], v0[1]); w.y = cvt_pk_bf16(v0[2], v0[3]); w.z = cvt_pk_bf16(v1[0], v1[1]); w.w = cvt_pk_bf16(v1[2], v1[3]);
                    *(u32x4*)(x1b + o) = w; }
                s += __shfl_xor(s, 16); s += __shfl_xor(s, 32);
                if (fq == 0) atomicAdd(ss + row, s); }
    }
};
struct EpiUp {
    static constexpr bool PERM = true;
    const float* ss; bf16_t* hid;
    __device__ __forceinline__ void operator()(const Acc& acc, const Unit& u, int wr, int wc, int fr, int fq) const {
        const int row0 = u.pm * BM + wr * 64 + fr, col0 = u.pn * BM + wc * 32 + 8 * fq;
#pragma unroll
        for (int ai = 0; ai < 2; ++ai)
#pragma unroll
            for (int m = 0; m < 4; ++m) { const size_t row = (size_t)(row0 + ai * HALF + m * 16); const float rs = rsqrtf(ss[row] * (1.f / 2048.f) + 1e-6f);
#pragma unroll
                for (int bj = 0; bj < 2; ++bj) { f32x4 v0 = acc[ai][bj][m][0] * rs, v1 = acc[ai][bj][m][1] * rs;
#pragma unroll
                    for (int j = 0; j < 4; ++j) { const float a = fmaxf(v0[j], 0.f), b = fmaxf(v1[j], 0.f); v0[j] = a * a; v1[j] = b * b; }
                    u32x4 w; w.x = cvt_pk_bf16(v0[0], v0[1]); w.y = cvt_pk_bf16(v0[2], v0[3]); w.z = cvt_pk_bf16(v1[0], v1[1]); w.w = cvt_pk_bf16(v1[2], v1[3]);
                    *(u32x4*)(hid + row * 8192 + col0 + bj * HALF) = w; } }
    }
};
struct EpiDown {
    static constexpr bool PERM = false;
    float* x; const bf16_t* x1b;
    __device__ __forceinline__ void operator()(const Acc& acc, const Unit& u, int wr, int wc, int fr, int fq) const {
        const int row0 = u.pm * BM + wr * 64 + fr, col0 = u.pn * BM + wc * 32 + 4 * fq;
#pragma unroll
        for (int ai = 0; ai < 2; ++ai)
#pragma unroll
            for (int m = 0; m < 4; ++m) { const size_t ro = (size_t)(row0 + ai * HALF + m * 16) * 2048 + col0;
#pragma unroll
                for (int bj = 0; bj < 2; ++bj)
#pragma unroll
                    for (int n = 0; n < 2; ++n) { const size_t o = ro + bj * HALF + n * 16; const u32x2 r = *(const u32x2*)(x1b + o);
                        f32x4 v = acc[ai][bj][m][n]; v[0] += bf_lo(r.x); v[1] += bf_hi(r.x); v[2] += bf_lo(r.y); v[3] += bf_hi(r.y); *(f32x4*)(x + o) = v; } }
    }
};
struct EpiDownPart {
    static constexpr bool PERM = false;
    float* part;
    __device__ __forceinline__ void operator()(const Acc& acc, const Unit& u, int wr, int wc, int fr, int fq) const {
        const int row0 = (u.pm - 32) * BM + wr * 64 + fr, col0 = u.pn * BM + wc * 32 + 4 * fq; float* pb = part + (size_t)(u.k0 >> 4) * 1024 * 2048;
#pragma unroll
        for (int ai = 0; ai < 2; ++ai)
#pragma unroll
            for (int m = 0; m < 4; ++m) { float* rowp = pb + (size_t)(row0 + ai * HALF + m * 16) * 2048 + col0;
#pragma unroll
                for (int bj = 0; bj < 2; ++bj)
#pragma unroll
                    for (int n = 0; n < 2; ++n) *(f32x4*)(rowp + bj * HALF + n * 16) = acc[ai][bj][m][n]; }
    }
};
}

__device__ __forceinline__ int win_map(int nd) { return nd < 6144 ? nd : (nd < 13312 ? nd + 16 : (nd < 13328 ? nd - 13312 + 6144 : -1)); }
__device__ __forceinline__ void tconv_tile(LAS float* T, const float* __restrict__ src, int K, int Nsrc, bf16_t* __restrict__ dst,
                                           const float* __restrict__ kscale, bool winmap, int t) {
    const int lane = threadIdx.x & 63; const int ntk = K / 64;
    const int tk = t % ntk, tn = t / ntk, k0 = tk * 64, n0 = tn * 64;
    f32x4 v[16];
#pragma unroll
    for (int i = 0; i < 16; ++i) { const int q = lane + 64 * i, kr = q >> 4, c4 = q & 15; const int nd = n0 + c4 * 4; const int ns = winmap ? win_map(nd) : nd;
        v[i] = (f32x4){0.f, 0.f, 0.f, 0.f};
        if (ns >= 0) v[i] = *(const f32x4*)(src + (size_t)(k0 + kr) * Nsrc + ns);
        if (kscale) v[i] *= kscale[k0 + kr]; }
#pragma unroll
    for (int i = 0; i < 16; ++i) { const int q = lane + 64 * i, kr = q >> 4, c4 = q & 15; LAS float* tp = T + kr * 65 + c4 * 4; tp[0] = v[i][0]; tp[1] = v[i][1]; tp[2] = v[i][2]; tp[3] = v[i][3]; }
    const int nl = lane >> 3, kg = lane & 7;
#pragma unroll
    for (int g = 0; g < 8; ++g) { const int nn = g * 8 + nl; float e[8];
#pragma unroll
        for (int j = 0; j < 8; ++j) e[j] = T[(kg * 8 + j) * 65 + nn];
        u32x4 w; w.x = cvt_pk_bf16(e[0], e[1]); w.y = cvt_pk_bf16(e[2], e[3]); w.z = cvt_pk_bf16(e[4], e[5]); w.w = cvt_pk_bf16(e[6], e[7]);
        *(u32x4*)(dst + (size_t)(n0 + nn) * K + k0 + kg * 8) = w; }
}
__device__ __forceinline__ void tconv(LAS unsigned char* lds, const float* __restrict__ src, int K, int Nsrc, bf16_t* __restrict__ dst, int Ndst,
                                      const float* __restrict__ kscale, bool winmap, int& tbase, int bid, int G) {
    const int wid = threadIdx.x >> 6; const int ntile = (K / 64) * (Ndst / 64);
    LAS float* T = (LAS float*)(lds + wid * 16640);
    const int W = G * 8, me = bid * 8 + wid;
    int first = (me - (tbase % W) + W) % W;
    for (int t = first; t < ntile; t += W) tconv_tile(T, src, K, Nsrc, dst, kscale, winmap, t);
    tbase += ntile;
}
__device__ __forceinline__ void phase0(LAS unsigned char* lds, const P& p, int bid, int G) {
    unsigned char* ws = p.ws; const int tid = threadIdx.x, lane = tid & 63, wid = tid >> 6;
    if (bid == 0 && tid == 0) ((unsigned*)ws)[16] = 0u;
    for (int i = bid * NTHR + tid; i < 2 * 9216; i += G * NTHR) ((float*)(ws + WS_SS1))[i] = 0.f;
    for (int row = bid * 8 + wid; row < 10240; row += G * 8) {
        const float* src = row < 8192 ? p.in[0] + (size_t)row * 2048 : (row < 9216 ? p.in[1] + (size_t)(row - 8192) * 2048 : p.in[2] + (size_t)(row - 9216) * 2048);
        const float* g = row < 9216 ? p.in[9] : p.in[22];
        bf16_t* dst = row < 9216 ? (bf16_t*)(ws + WS_XN) + (size_t)row * 2048 : (bf16_t*)(ws + WS_MEMN) + (size_t)(row - 9216) * 2048;
        f32x4 v[8]; float s = 0.f;
#pragma unroll
        for (int i = 0; i < 8; ++i) { v[i] = *(const f32x4*)(src + (i * 64 + lane) * 4); s += v[i][0] * v[i][0] + v[i][1] * v[i][1] + v[i][2] * v[i][2] + v[i][3] * v[i][3]; }
#pragma unroll
        for (int o = 32; o >= 1; o >>= 1) s += __shfl_xor(s, o);
        const float rs = rsqrtf(s * (1.f / 2048.f) + 1e-6f);
#pragma unroll
        for (int i = 0; i < 8; ++i) { const f32x4 gg = *(const f32x4*)(g + (i * 64 + lane) * 4); const f32x4 y = v[i] * rs * gg;
            u32x2 w; w.x = cvt_pk_bf16(y[0], y[1]); w.y = cvt_pk_bf16(y[2], y[3]); *(u32x2*)(dst + (i * 64 + lane) * 4) = w; }
    }
    int tb = 0;
    tconv(lds, p.in[10], 2048, 13328, (bf16_t*)(ws + WS_WIN), 13568, nullptr, true, tb, bid, G);
    tconv(lds, p.in[23], 2048, 2048, (bf16_t*)(ws + WS_WMKV), 2048, nullptr, false, tb, bid, G);
    for (int nb = 0; nb < 8; ++nb) {
        tconv(lds, p.in[13] + (size_t)nb * 16384, 128, 128, (bf16_t*)(ws + WS_WRG) + (size_t)nb * 32768, 128, nullptr, false, tb, bid, G);
        tconv(lds, p.in[15] + (size_t)nb * 16384, 128, 128, (bf16_t*)(ws + WS_WRG) + (size_t)nb * 32768 + 16384, 128, nullptr, false, tb, bid, G);
    }
}

constexpr int GPC = 36864;
__device__ __forceinline__ void gdn_prep_item(LAS unsigned char* lds, const P& p, int item) {
    const int tid = threadIdx.x, lane = tid & 63, wid = __builtin_amdgcn_readfirstlane(tid >> 6), fr = lane & 15, fq = lane >> 4;
    const int c = item & 31, h = (item >> 5) & 7, b = item >> 8;
    const int tok0 = b * 2048 + c * 64;
    const bf16_t* PROJ = (const bf16_t*)(p.ws + WS_PROJ); const float* GBA = (const float*)(p.ws + WS_GBA);
    bf16_t* gp = (bf16_t*)(p.ws + WS_GP) + (size_t)item * GPC;
    LAS bf16_t* qs = (LAS bf16_t*)(lds + 0);
    LAS bf16_t* ks = (LAS bf16_t*)(lds + 17408);
    LAS bf16_t* vs = (LAS bf16_t*)(lds + 34816);
    LAS float* Mf = (LAS float*)(lds + 52224);
    LAS float* sc = (LAS float*)(lds + 114688);
    __syncthreads();
    if (wid == 0) {
        const float gb = GBA[(size_t)(tok0 + lane) * 16 + h], ga = GBA[(size_t)(tok0 + lane) * 16 + 8 + h];
        const float beta = sigm(gb);
        const float g = -__expf(p.in[19][h]) * softplusf(ga + p.in[20][h]);
        float gc = g;
#pragma unroll
        for (int o = 1; o < 64; o <<= 1) { const float t = __shfl_up(gc, o); if (lane >= o) gc += t; }
        const float gl = __shfl(gc, 63);
        sc[lane] = gc; sc[64 + lane] = beta; sc[128 + lane] = __expf(gc); sc[192 + lane] = __expf(gl - gc); sc[256 + lane] = beta * __expf(gc);
        if (lane == 0) ((float*)(p.ws + WS_DEC))[item] = __expf(gl);
    }
    {
        const int r = tid >> 3, seg = tid & 7;
#pragma unroll
        for (int mat = 0; mat < 3; ++mat) {
            const int chm = mat * 1024 + h * 128 + seg * 16;
            float a[16];
#pragma unroll
            for (int i = 0; i < 16; ++i) a[i] = 0.f;
#pragma unroll
            for (int j = 0; j < 4; ++j) { const int t = c * 64 + r - 3 + j;
                if (t >= 0) { const bf16_t* src = PROJ + (size_t)(b * 2048 + t) * NPROJ + C_GQ + chm; const u32x4 x0 = *(const u32x4*)src, x1 = *(const u32x4*)(src + 8);
                    const float* w = p.in[18] + j * 3072 + chm; const f32x4 w0 = *(const f32x4*)w, w1 = *(const f32x4*)(w + 4), w2 = *(const f32x4*)(w + 8), w3 = *(const f32x4*)(w + 12);
                    a[0] += w0[0] * bf_lo(x0.x); a[1] += w0[1] * bf_hi(x0.x); a[2] += w0[2] * bf_lo(x0.y); a[3] += w0[3] * bf_hi(x0.y);
                    a[4] += w1[0] * bf_lo(x0.z); a[5] += w1[1] * bf_hi(x0.z); a[6] += w1[2] * bf_lo(x0.w); a[7] += w1[3] * bf_hi(x0.w);
                    a[8] += w2[0] * bf_lo(x1.x); a[9] += w2[1] * bf_hi(x1.x); a[10] += w2[2] * bf_lo(x1.y); a[11] += w2[3] * bf_hi(x1.y);
                    a[12] += w3[0] * bf_lo(x1.z); a[13] += w3[1] * bf_hi(x1.z); a[14] += w3[2] * bf_lo(x1.w); a[15] += w3[3] * bf_hi(x1.w); } }
            float ss = 0.f;
#pragma unroll
            for (int i = 0; i < 16; ++i) { a[i] = siluf(a[i]); ss += a[i] * a[i]; }
            if (mat < 2) { ss += __shfl_xor(ss, 1); ss += __shfl_xor(ss, 2); ss += __shfl_xor(ss, 4);
                float rn = rsqrtf(ss + 1e-6f); if (mat == 0) rn *= 0.08838834764831845f;
#pragma unroll
                for (int i = 0; i < 16; ++i) a[i] *= rn; }
            LAS bf16_t* dst = (mat == 0 ? qs : (mat == 1 ? ks : vs)) + r * 136 + seg * 16;
            u32x4 w0, w1; w0.x = cvt_pk_bf16(a[0], a[1]); w0.y = cvt_pk_bf16(a[2], a[3]); w0.z = cvt_pk_bf16(a[4], a[5]); w0.w = cvt_pk_bf16(a[6], a[7]);
            w1.x = cvt_pk_bf16(a[8], a[9]); w1.y = cvt_pk_bf16(a[10], a[11]); w1.z = cvt_pk_bf16(a[12], a[13]); w1.w = cvt_pk_bf16(a[14], a[15]);
            *(LAS u32x4*)dst = w0; *(LAS u32x4*)(dst + 8) = w1;
        }
    }
    LDS_BAR();
    {
        const int r = tid & 63, seg = tid >> 6; const float ed = sc[192 + r];
        bf16_t* kdt = gp + 24576;
#pragma unroll
        for (int i = 0; i < 16; ++i) { const int ch = seg * 16 + i; const float kv = bf2f(ks[r * 136 + ch]);
            kdt[ch * 64 + r] = f2bf(kv * ed); }
    }
    {
        const int r = tid >> 3, seg = tid & 7; const float eg = sc[128 + r];
        const u32x4 x0 = *(const LAS u32x4*)(qs + r * 136 + seg * 16), x1 = *(const LAS u32x4*)(qs + r * 136 + seg * 16 + 8);
        u32x4 w0, w1;
        w0.x = cvt_pk_bf16(bf_lo(x0.x) * eg, bf_hi(x0.x) * eg); w0.y = cvt_pk_bf16(bf_lo(x0.y) * eg, bf_hi(x0.y) * eg); w0.z = cvt_pk_bf16(bf_lo(x0.z) * eg, bf_hi(x0.z) * eg); w0.w = cvt_pk_bf16(bf_lo(x0.w) * eg, bf_hi(x0.w) * eg);
        w1.x = cvt_pk_bf16(bf_lo(x1.x) * eg, bf_hi(x1.x) * eg); w1.y = cvt_pk_bf16(bf_lo(x1.y) * eg, bf_hi(x1.y) * eg); w1.z = cvt_pk_bf16(bf_lo(x1.z) * eg, bf_hi(x1.z) * eg); w1.w = cvt_pk_bf16(bf_lo(x1.w) * eg, bf_hi(x1.w) * eg);
        bf16_t* d = gp + 8192 + r * 128 + seg * 16; *(u32x4*)d = w0; *(u32x4*)(d + 8) = w1;
    }
    {
        bf16_t* at = gp + 32768;
#pragma unroll
        for (int i4 = 0; i4 < 4; ++i4) { const int T = wid * 4 + i4, which = T >> 4, it = (T >> 2) & 3, jt = T & 3;
            if (jt <= it) {
                f32x4 acc = (f32x4){0.f, 0.f, 0.f, 0.f}; const LAS bf16_t* A = which ? qs : ks;
                bf16x8 fa[4], fb[4];
#pragma unroll
                for (int k = 0; k < 4; ++k) { fa[k] = *(const LAS bf16x8*)(A + (16 * it + fr) * 136 + 32 * k + fq * 8); fb[k] = *(const LAS bf16x8*)(ks + (16 * jt + fr) * 136 + 32 * k + fq * 8); }
#pragma unroll
                for (int k = 0; k < 4; ++k) acc = MFMA16(fa[k], fb[k], acc);
#pragma unroll
                for (int r = 0; r < 4; ++r) { const int i = 16 * it + fq * 4 + r, j = 16 * jt + fr; const float d = (j <= i) ? __expf(sc[i] - sc[j]) : 0.f;
                    if (!which) { if (j < i) Mf[i * 64 + j] = sc[64 + i] * acc[r] * d; }
                    else at[i * 64 + j] = f2bf(acc[r] * d); }
            } else if (which) {
#pragma unroll
                for (int r = 0; r < 4; ++r) at[(16 * it + fq * 4 + r) * 64 + 16 * jt + fr] = (bf16_t)0;
            }
        }
    }
    LDS_BAR();
    if (wid < 4) {
        const bool isk = wid >= 2; const int col = (wid & 1) * 64 + lane;
        float X[64]; int zoff; asm volatile("v_mov_b32 %0, 0" : "=v"(zoff)); const LAS float* Mz = Mf + zoff; const LAS float* scz = sc + zoff + (isk ? 256 : 64);
        const LAS bf16_t* src = (const LAS bf16_t*)(lds + (isk ? 17408 : 34816)) + col + zoff;
#pragma unroll
        for (int i = 0; i < 64; ++i) {
            f32x4 mrow[(i + 3) / 4 > 0 ? (i + 3) / 4 : 1];
#pragma unroll
            for (int v = 0; v < (i + 3) / 4; ++v) mrow[v] = *(const LAS f32x4*)(Mz + i * 64 + 4 * v);
            float a0 = bf2f(src[i * 136]) * scz[i], a1 = 0.f, a2 = 0.f, a3 = 0.f;
#pragma unroll
            for (int j = 0; j < i; ++j) { const float mv = mrow[j >> 2][j & 3];
                if ((j & 3) == 0) a0 -= mv * X[j]; else if ((j & 3) == 1) a1 -= mv * X[j]; else if ((j & 3) == 2) a2 -= mv * X[j]; else a3 -= mv * X[j]; }
            X[i] = (a0 + a1) + (a2 + a3);
            asm volatile("" ::: "memory");
        }
        if (!isk) {
            bf16_t* d = gp + 16384 + col * 64;
#pragma unroll
            for (int e = 0; e < 8; ++e) { u32x4 w; w.x = cvt_pk_bf16(X[8 * e], X[8 * e + 1]); w.y = cvt_pk_bf16(X[8 * e + 2], X[8 * e + 3]); w.z = cvt_pk_bf16(X[8 * e + 4], X[8 * e + 5]); w.w = cvt_pk_bf16(X[8 * e + 6], X[8 * e + 7]);
                *(u32x4*)(d + 8 * e) = w; }
        } else {
#pragma unroll
            for (int i = 0; i < 64; ++i) gp[i * 128 + col] = f2bf(X[i]);
        }
    }
}

__device__ __forceinline__ void gdn_seq_item(LAS unsigned char* lds, const P& p, int item) {
    const int tid = threadIdx.x, lane = tid & 63, wid = __builtin_amdgcn_readfirstlane(tid >> 6), fr = lane & 15, fq = lane >> 4;
    const int b = item >> 3, h = item & 7;
    const bf16_t* gp = (const bf16_t*)(p.ws + WS_GP) + (size_t)item * 32 * GPC;
    const float* DEC = (const float*)(p.ws + WS_DEC) + item * 32;
    const bf16_t* PROJ = (const bf16_t*)(p.ws + WS_PROJ);
    bf16_t* YG = (bf16_t*)(p.ws + WS_YCAT) + (size_t)9216 * 1024;
    LAS bf16_t* KCD = (LAS bf16_t*)(lds + 0);
    LAS bf16_t* QG = (LAS bf16_t*)(lds + 17408);
    LAS bf16_t* VT = (LAS bf16_t*)(lds + 34816);
    LAS bf16_t* KDT = (LAS bf16_t*)(lds + 53248);
    LAS bf16_t* AT = (LAS bf16_t*)(lds + 71680);
    LAS bf16_t* ST = (LAS bf16_t*)(lds + 80896);
    LAS bf16_t* VNT = (LAS bf16_t*)(lds + 115712);
    LAS float* SSQ = (LAS float*)(lds + 134144);
#if DBG_SEQ_SUM
    { float* so = p.out + O_GSP + (size_t)item * 16384;
      for (int e = tid; e < 16384; e += NTHR) { const int dk = e >> 7, dv = e & 127; float a = 0.f;
          for (int c = 0; c < 32; ++c) { const bf16_t* g = gp + (size_t)c * GPC; a += bf2f(g[(dk & 63) * 128 + dv]) + bf2f(g[16384 + dv * 64 + (dk & 63)]) + bf2f(g[8192 + (dk & 63) * 128 + dv]) + bf2f(g[24576 + dv * 64 + (dk & 63)]) + bf2f(g[32768 + (dk & 63) * 64 + (dv & 63)]) + DEC[c]; }
          so[e] = a; }
      for (int e = tid; e < 2048 * 128; e += NTHR) YG[((size_t)b * 2048 + (e >> 7)) * 1024 + h * 128 + (e & 127)] = 0;
      return; }
#endif
    u32x4 pf[9];
#define GS_LOAD(cc) do { _Pragma("unroll") for (int i = 0; i < 9; ++i) pf[i] = *(const u32x4*)(gp + (size_t)(cc) * GPC + (size_t)(tid + NTHR * i) * 8); } while (0)
#define GS_STORE() do { _Pragma("unroll") for (int i = 0; i < 9; ++i) { const int q = tid + NTHR * i; int off; \
        if (i < 2) off = 0 + (q >> 4) * 272 + (q & 15) * 16; else if (i < 4) off = 17408 + ((q - 1024) >> 4) * 272 + (q & 15) * 16; \
        else if (i < 6) off = 34816 + ((q - 2048) >> 3) * 144 + (q & 7) * 16; else if (i < 8) off = 53248 + ((q - 3072) >> 3) * 144 + (q & 7) * 16; \
        else off = 71680 + ((q - 4096) >> 3) * 144 + (q & 7) * 16; \
        *(LAS u32x4*)(lds + off) = pf[i]; } } while (0)
    __syncthreads();
    GS_LOAD(0);
    for (int i = tid; i < 34816 / 16; i += NTHR) *(LAS u32x4*)(lds + 80896 + i * 16) = (u32x4){0u, 0u, 0u, 0u};
    GS_STORE();
    f32x4 Sacc[8];
#pragma unroll
    for (int i = 0; i < 8; ++i) Sacc[i] = (f32x4){0.f, 0.f, 0.f, 0.f};
    __syncthreads();
    const int it = wid & 3, dvb = (wid >> 2) * 4;
    for (int c = 0; c < 32; ++c) {
        if (c + 1 < 32) GS_LOAD(c + 1);
        const float dec = DEC[c];
        u32x2 zpf[4];
        { const size_t gt = (size_t)b * 2048 + c * 64 + 16 * it + fr;
#pragma unroll
          for (int q = 0; q < 4; ++q) zpf[q] = *(const u32x2*)(PROJ + gt * NPROJ + C_GZ + h * 128 + 16 * (dvb + q) + fq * 4); }
        {
            bf16x8 a[4];
#pragma unroll
            for (int k = 0; k < 4; ++k) a[k] = *(const LAS bf16x8*)(KCD + (16 * it + fr) * 136 + 32 * k + fq * 8);
            bf16x8 sb[4][4]; u32x2 vvq[4];
#pragma unroll
            for (int q = 0; q < 4; ++q) {
#pragma unroll
                for (int k = 0; k < 4; ++k) sb[q][k] = *(const LAS bf16x8*)(ST + (16 * (dvb + q) + fr) * 136 + 32 * k + fq * 8);
                vvq[q] = *(const LAS u32x2*)(VT + (16 * (dvb + q) + fr) * 72 + 16 * it + fq * 4); }
#pragma unroll
            for (int q = 0; q < 4; ++q) { const int dvt = dvb + q; f32x4 acc = (f32x4){0.f, 0.f, 0.f, 0.f};
#pragma unroll
                for (int k = 0; k < 4; ++k) acc = MFMA16(a[k], sb[q][k], acc);
                const u32x2 vv = vvq[q];
                u32x2 w; w.x = cvt_pk_bf16(bf_lo(vv.x) - acc[0], bf_hi(vv.x) - acc[1]); w.y = cvt_pk_bf16(bf_lo(vv.y) - acc[2], bf_hi(vv.y) - acc[3]);
                *(LAS u32x2*)(VNT + (16 * dvt + fr) * 72 + 16 * it + fq * 4) = w; }
        }
        LDS_BAR();
        f32x4 oacc[4];
        {
            bf16x8 bq[4], ba[2];
#pragma unroll
            for (int k = 0; k < 4; ++k) bq[k] = *(const LAS bf16x8*)(QG + (16 * it + fr) * 136 + 32 * k + fq * 8);
#pragma unroll
            for (int k = 0; k < 2; ++k) ba[k] = *(const LAS bf16x8*)(AT + (16 * it + fr) * 72 + 32 * k + fq * 8);
            float s = 0.f;
#pragma unroll
            for (int q2 = 0; q2 < 4; q2 += 2) {
              bf16x8 sa[2][4], va[2][2];
#pragma unroll
              for (int e = 0; e < 2; ++e) {
#pragma unroll
                for (int k = 0; k < 4; ++k) sa[e][k] = *(const LAS bf16x8*)(ST + (16 * (dvb + q2 + e) + fr) * 136 + 32 * k + fq * 8);
#pragma unroll
                for (int k = 0; k < 2; ++k) va[e][k] = *(const LAS bf16x8*)(VNT + (16 * (dvb + q2 + e) + fr) * 72 + 32 * k + fq * 8); }
#pragma unroll
              for (int e = 0; e < 2; ++e) { const int q = q2 + e; f32x4 acc = (f32x4){0.f, 0.f, 0.f, 0.f};
#pragma unroll
                for (int k = 0; k < 4; ++k) acc = MFMA16(sa[e][k], bq[k], acc);
#pragma unroll
                for (int k = 0; k < 2; ++k) acc = MFMA16(va[e][k], ba[k], acc);
                oacc[q] = acc; s += acc[0] * acc[0] + acc[1] * acc[1] + acc[2] * acc[2] + acc[3] * acc[3]; }
            }
            s += __shfl_xor(s, 16); s += __shfl_xor(s, 32);
            if (fq == 0) SSQ[(wid >> 2) * 64 + 16 * it + fr] = s;
        }
        {
            bf16x8 a[2];
#pragma unroll
            for (int k = 0; k < 2; ++k) a[k] = *(const LAS bf16x8*)(KDT + (16 * wid + fr) * 72 + 32 * k + fq * 8);
            bf16x8 vb[8][2];
#pragma unroll
            for (int dvt = 0; dvt < 8; ++dvt)
#pragma unroll
                for (int k = 0; k < 2; ++k) vb[dvt][k] = *(const LAS bf16x8*)(VNT + (16 * dvt + fr) * 72 + 32 * k + fq * 8);
#pragma unroll
            for (int dvt = 0; dvt < 8; ++dvt) { f32x4 acc = Sacc[dvt] * dec;
#pragma unroll
                for (int k = 0; k < 2; ++k) acc = MFMA16(a[k], vb[dvt][k], acc);
                Sacc[dvt] = acc; }
        }
        LDS_BAR();
        {
#pragma unroll
            for (int dvt = 0; dvt < 8; ++dvt) { u32x2 w; w.x = cvt_pk_bf16(Sacc[dvt][0], Sacc[dvt][1]); w.y = cvt_pk_bf16(Sacc[dvt][2], Sacc[dvt][3]);
                *(LAS u32x2*)(ST + (16 * dvt + fr) * 136 + 16 * wid + fq * 4) = w; }
            const float tot = SSQ[16 * it + fr] + SSQ[64 + 16 * it + fr]; const float rs = rsqrtf(tot * (1.f / 128.f) + 1e-6f);
            const size_t gtok = (size_t)b * 2048 + c * 64 + 16 * it + fr;
#pragma unroll
            for (int q = 0; q < 4; ++q) { const int dv = 16 * (dvb + q) + fq * 4;
                const u32x2 z = zpf[q]; const f32x4 gn = *(const f32x4*)(p.in[21] + dv);
                u32x2 w; w.x = cvt_pk_bf16(DBGFIN(oacc[q][0] * rs * gn[0] * bf_lo(z.x)), DBGFIN(oacc[q][1] * rs * gn[1] * bf_hi(z.x)));
                w.y = cvt_pk_bf16(DBGFIN(oacc[q][2] * rs * gn[2] * bf_lo(z.y)), DBGFIN(oacc[q][3] * rs * gn[3] * bf_hi(z.y)));
                *(u32x2*)(YG + gtok * 1024 + h * 128 + dv) = w; }
            if (c + 1 < 32) GS_STORE();
        }
        LDS_BAR();
    }
    {
        float* so = p.out + O_GSP + (size_t)item * 16384;
#pragma unroll
        for (int dvt = 0; dvt < 8; ++dvt)
#pragma unroll
            for (int r = 0; r < 4; ++r) so[(16 * wid + fq * 4 + r) * 128 + 16 * dvt + fr] = Sacc[dvt][r];
    }
#undef GS_LOAD
#undef GS_STORE
}

template <bool PROMPT>
__device__ __forceinline__ void rglru_item(LAS unsigned char* lds, const P& p, int item) {
    const int tid = threadIdx.x, lane = tid & 63, wid = __builtin_amdgcn_readfirstlane(tid >> 6), fr = lane & 15, fq = lane >> 4;
    const int q = item & 3, n = (item >> 2) & 7, bb0 = item >> 5;
    const int gq0 = n * 128 + 32 * q;
    const bf16_t* PROJ = (const bf16_t*)(p.ws + WS_PROJ);
    bf16_t* YR = (bf16_t*)(p.ws + WS_YCAT);
    LAS bf16_t* WL = (LAS bf16_t*)(lds + 0);
    LAS bf16_t* XA = (LAS bf16_t*)(lds + 17408);
    LAS bf16_t* RG = (LAS bf16_t*)(lds + 52224);
    LAS float* WT = (LAS float*)(lds + 62464);
    LAS float* HC = (LAS float*)(lds + 64512);
    LAS float* PAR = (LAS float*)(lds + 64768);
    __syncthreads();
    {   const bf16_t* wsrc = (const bf16_t*)(p.ws + WS_WRG) + (size_t)n * 32768;
#pragma unroll
        for (int i = 0; i < 2; ++i) { const int c = tid + NTHR * i, r = c >> 4, c8 = c & 15; const int srow = (r < 32) ? (32 * q + r) : (128 + 32 * q + (r - 32));
            *(LAS u32x4*)(WL + r * 136 + c8 * 8) = *(const u32x4*)(wsrc + (size_t)srow * 128 + c8 * 8); }
        if (tid < 64) HC[tid] = 0.f;
        if (tid < 32) { PAR[tid] = p.in[14][gq0 + tid]; PAR[32 + tid] = p.in[16][gq0 + tid]; PAR[64 + tid] = -8.f * softplusf(-p.in[17][gq0 + tid]); } }
    const int ntile = PROMPT ? 16 : 1;
    const int crow = tid >> 2, cpart = tid & 3;
    const int cg = tid & 15, r0 = (tid >> 4) * 4;
    const int gc8 = n * 128 + 8 * cg;
    f32x4 wlo[4], whi[4], blo, bhi;
#pragma unroll
    for (int j = 0; j < 4; ++j) { wlo[j] = *(const f32x4*)(p.in[11] + j * 1024 + gc8); whi[j] = *(const f32x4*)(p.in[11] + j * 1024 + gc8 + 4); }
    blo = *(const f32x4*)(p.in[12] + gc8); bhi = *(const f32x4*)(p.in[12] + gc8 + 4);
    u32x4 xr[7], rgv;
#define RG_LOAD(TT) do { const size_t gr_ = PROMPT ? (size_t)bb0 * 2048 + (TT) * 128 + crow : (size_t)8192 + bb0 * 128 + crow; \
        rgv = *(const u32x4*)(PROJ + gr_ * NPROJ + C_RG + gq0 + 8 * cpart); \
        _Pragma("unroll") for (int k = 0; k < 7; ++k) { const int t_ = PROMPT ? (TT) * 128 + r0 - 3 + k : (r0 & 7) - 3 + k; const int tc_ = t_ > 0 ? t_ : 0; \
            const size_t sr_ = PROMPT ? (size_t)bb0 * 2048 + tc_ : (size_t)8192 + (bb0 * 16 + (r0 >> 3)) * 8 + tc_; \
            xr[k] = *(const u32x4*)(PROJ + sr_ * NPROJ + C_RX + gc8); } } while (0)
    RG_LOAD(0);
    for (int tt = 0; tt < ntile; ++tt) {
        const size_t grow_c = PROMPT ? (size_t)bb0 * 2048 + tt * 128 + crow : (size_t)8192 + bb0 * 128 + crow;
        {
#pragma unroll
            for (int rr = 0; rr < 4; ++rr) { f32x4 alo = blo, ahi = bhi;
#pragma unroll
                for (int j = 0; j < 4; ++j) { const int t = PROMPT ? tt * 128 + r0 + rr - 3 + j : (r0 & 7) + rr - 3 + j;
                    if (t >= 0) { const u32x4 x = xr[rr + j];
                        alo[0] += wlo[j][0] * bf_lo(x.x); alo[1] += wlo[j][1] * bf_hi(x.x); alo[2] += wlo[j][2] * bf_lo(x.y); alo[3] += wlo[j][3] * bf_hi(x.y);
                        ahi[0] += whi[j][0] * bf_lo(x.z); ahi[1] += whi[j][1] * bf_hi(x.z); ahi[2] += whi[j][2] * bf_lo(x.w); ahi[3] += whi[j][3] * bf_hi(x.w);
                    } else if (!PROMPT) { const float* srcf = p.in[5] + (size_t)((bb0 * 16 + (r0 >> 3)) * 3 + 3 + t) * 1024 + gc8;
                        const f32x4 x0 = *(const f32x4*)srcf, x1 = *(const f32x4*)(srcf + 4); alo += wlo[j] * x0; ahi += whi[j] * x1; }
                }
                u32x4 w; w.x = cvt_pk_bf16(alo[0], alo[1]); w.y = cvt_pk_bf16(alo[2], alo[3]); w.z = cvt_pk_bf16(ahi[0], ahi[1]); w.w = cvt_pk_bf16(ahi[2], ahi[3]);
                *(LAS u32x4*)(XA + (r0 + rr) * 136 + 8 * cg) = w; }
            *(LAS u32x4*)(RG + crow * 40 + 8 * cpart) = rgv;
            if (tt + 1 < ntile) RG_LOAD(tt + 1);
        }
        LDS_BAR();
        f32x4 acc[4];
        {   bf16x8 a[4];
#pragma unroll
            for (int k = 0; k < 4; ++k) a[k] = *(const LAS bf16x8*)(XA + (16 * wid + fr) * 136 + 32 * k + fq * 8);
            bf16x8 wf[4][4];
#pragma unroll
            for (int nt = 0; nt < 4; ++nt)
#pragma unroll
                for (int k = 0; k < 4; ++k) wf[nt][k] = *(const LAS bf16x8*)(WL + (16 * nt + fr) * 136 + 32 * k + fq * 8);
#pragma unroll
            for (int nt = 0; nt < 4; ++nt) { f32x4 c = (f32x4){0.f, 0.f, 0.f, 0.f};
#pragma unroll
                for (int k = 0; k < 4; ++k) c = MFMA16(a[k], wf[nt][k], c);
                acc[nt] = c; } }
        float eA[2], eU[2]; float xcv[2][4], pbx[2], pba[2], pc8[2];
#pragma unroll
        for (int nt = 0; nt < 2; ++nt) { const int ch = 16 * nt + fr; pbx[nt] = PAR[ch]; pba[nt] = PAR[32 + ch]; pc8[nt] = PAR[64 + ch];
#pragma unroll
            for (int r = 0; r < 4; ++r) xcv[nt][r] = bf2f(XA[(16 * wid + 4 * fq + r) * 136 + 32 * q + ch]); }
#pragma unroll
        for (int nt = 0; nt < 2; ++nt) { const int ch = 16 * nt + fr;
            const float bx = pbx[nt], ba = pba[nt], c8 = pc8[nt];
#pragma unroll
            for (int r = 0; r < 4; ++r) { const float gi = sigm(acc[nt][r] + bx), gr = sigm(acc[nt + 2][r] + ba); const float la = c8 * gr;
                const float av = __expf(la), mult = sqrtf(fmaxf(1.f - av * av, 0.f)); const float xc = xcv[nt][r];
                acc[nt][r] = mult * gi * xc; acc[nt + 2][r] = av; }
            float A = acc[nt + 2][0], U = acc[nt][0];
#pragma unroll
            for (int r = 1; r < 4; ++r) { U = acc[nt + 2][r] * U + acc[nt][r]; A *= acc[nt + 2][r]; }
            if (PROMPT) {
                float A1 = __shfl_up(A, 16), U1 = __shfl_up(U, 16); if (fq >= 1) { U = A * U1 + U; A = A * A1; }
                A1 = __shfl_up(A, 32); U1 = __shfl_up(U, 32); if (fq >= 2) { U = A * U1 + U; A = A * A1; }
                float Ae = __shfl_up(A, 16), Ue = __shfl_up(U, 16); if (fq == 0) { Ae = 1.f; Ue = 0.f; }
                eA[nt] = Ae; eU[nt] = Ue;
                if (fq == 3) { WT[(wid * 32 + ch) * 2] = A; WT[(wid * 32 + ch) * 2 + 1] = U; }
            } else {
                float Ae = __shfl_up(A, 16), Ue = __shfl_up(U, 16); if ((fq & 1) == 0) { Ae = 1.f; Ue = 0.f; }
                eA[nt] = Ae; eU[nt] = Ue;
            }
        }
        LDS_BAR();
#pragma unroll
        for (int nt = 0; nt < 2; ++nt) { const int ch = 16 * nt + fr, gch = gq0 + ch;
            float hv;
            if (PROMPT) { hv = HC[(tt & 1) * 32 + ch];
                for (int w2 = 0; w2 < wid; ++w2) hv = WT[(w2 * 32 + ch) * 2] * hv + WT[(w2 * 32 + ch) * 2 + 1];
            } else hv = p.in[6][(size_t)(bb0 * 16 + wid * 2 + (fq >> 1)) * 1024 + gch];
            hv = eA[nt] * hv + eU[nt];
#pragma unroll
            for (int r = 0; r < 4; ++r) { hv = acc[nt + 2][r] * hv + acc[nt][r];
                LAS bf16_t* e = RG + (16 * wid + 4 * fq + r) * 40 + ch; *e = f2bf(hv * bf2f(*e)); }
            if (PROMPT) { if (wid == 7 && fq == 3) { HC[((tt & 1) ^ 1) * 32 + ch] = hv; if (tt == 15) p.out[O_RHP + (size_t)bb0 * 1024 + gch] = hv; } }
            else { if (fq & 1) p.out[O_RHS + (size_t)(bb0 * 16 + wid * 2 + (fq >> 1)) * 1024 + gch] = hv; }
        }
        LDS_BAR();
        *(u32x4*)(YR + grow_c * 1024 + gq0 + 8 * cpart) = *(const LAS u32x4*)(RG + crow * 40 + 8 * cpart);
    }
#undef RG_LOAD
}

__device__ __forceinline__ void gdn_sample_pass(LAS unsigned char* lds, const P& p, int pass) {
    const int tid = threadIdx.x, lane = tid & 63, sub = tid >> 8, idx = tid & 255, v = idx >> 1, kh = idx & 1, wv = (tid >> 6) & 3;
    const int item = pass * 2 + sub, b = item >> 3, h = item & 7;
    const bf16_t* PROJ = (const bf16_t*)(p.ws + WS_PROJ); const float* GBA = (const float*)(p.ws + WS_GBA);
    bf16_t* YG = (bf16_t*)(p.ws + WS_YCAT) + (size_t)9216 * 1024;
    LAS float* qv = (LAS float*)(lds + sub * 16896);
    LAS float* kv = qv + 1024;
    LAS float* vv = kv + 1024;
    LAS float* ov = vv + 1024;
    LAS float* red = ov + 1024;
    LAS float* db = red + 96;
    __syncthreads();
    {
        float yq[8], yk[8];
#pragma unroll
        for (int mat = 0; mat < 3; ++mat) { const int ch = mat * 1024 + h * 128 + v; float x[11];
#pragma unroll
            for (int j = 0; j < 3; ++j) x[j] = p.in[7][(size_t)(b * 3 + j) * 3072 + ch];
#pragma unroll
            for (int t = 0; t < 8; ++t) x[3 + t] = bf2f(PROJ[(size_t)(8192 + b * 8 + t) * NPROJ + C_GQ + ch]);
            const float w0 = p.in[18][ch], w1 = p.in[18][3072 + ch], w2 = p.in[18][6144 + ch], w3 = p.in[18][9216 + ch];
#pragma unroll
            for (int t = 0; t < 8; ++t) { const float y = siluf(w0 * x[t] + w1 * x[t + 1] + w2 * x[t + 2] + w3 * x[t + 3]); if (mat == 0) yq[t] = y; else if (mat == 1) yk[t] = y; else if (kh == 0) vv[t * 128 + v] = y; } }
#pragma unroll
        for (int t = 0; t < 8; ++t) { float sq = kh ? 0.f : yq[t] * yq[t], sk = kh ? 0.f : yk[t] * yk[t];
#pragma unroll
            for (int o = 32; o >= 1; o >>= 1) { sq += __shfl_xor(sq, o); sk += __shfl_xor(sk, o); }
            if (lane == 0) { red[wv * 8 + t] = sq; red[32 + wv * 8 + t] = sk; } }
        if (idx < 8) { const float* gr = GBA + (size_t)(8192 + b * 8 + idx) * 16; db[8 + idx] = sigm(gr[h]); db[idx] = __expf(-__expf(p.in[19][h]) * softplusf(gr[8 + h] + p.in[20][h])); }
        __syncthreads();
        if (kh == 0) {
#pragma unroll
            for (int t = 0; t < 8; ++t) { const float rq = rsqrtf(red[t] + red[8 + t] + red[16 + t] + red[24 + t] + 1e-6f) * 0.08838834764831845f, rk = rsqrtf(red[32 + t] + red[40 + t] + red[48 + t] + red[56 + t] + 1e-6f);
                qv[t * 128 + v] = yq[t] * rq; kv[t * 128 + v] = yk[t] * rk; } }
    }
    float Sc[64];
    { const float* s0 = p.in[8] + (size_t)item * 16384 + (size_t)kh * 64 * 128 + v;
#pragma unroll
        for (int k = 0; k < 64; ++k) Sc[k] = s0[k * 128]; }
    __syncthreads();
#pragma unroll 1
    for (int t = 0; t < 8; ++t) {
        const float dect = db[t], betat = db[8 + t], vt = vv[t * 128 + v];
        const LAS float* kt = kv + t * 128 + kh * 64; const LAS float* qt = qv + t * 128 + kh * 64;
        f32x4 kreg[16];
#pragma unroll
        for (int k = 0; k < 16; ++k) kreg[k] = *(const LAS f32x4*)(kt + 4 * k);
        float d0 = 0.f, d1 = 0.f, d2 = 0.f, d3 = 0.f;
#pragma unroll
        for (int k = 0; k < 64; k += 4) { const f32x4 kk = kreg[k >> 2]; d0 += Sc[k] * kk[0]; d1 += Sc[k + 1] * kk[1]; d2 += Sc[k + 2] * kk[2]; d3 += Sc[k + 3] * kk[3]; }
        float dot = (d0 + d1) + (d2 + d3); dot += __shfl_xor(dot, 1);
        const float rr = betat * (vt - dect * dot);
        float o0 = 0.f, o1 = 0.f, o2 = 0.f, o3 = 0.f;
#pragma unroll
        for (int hh = 0; hh < 2; ++hh) { f32x4 qreg[8];
#pragma unroll
            for (int k = 0; k < 8; ++k) qreg[k] = *(const LAS f32x4*)(qt + 32 * hh + 4 * k);
#pragma unroll
            for (int k8 = 0; k8 < 8; ++k8) { const int k = 32 * hh + 4 * k8; const f32x4 kk = kreg[k >> 2], qq = qreg[k8];
                Sc[k] = dect * Sc[k] + kk[0] * rr; Sc[k + 1] = dect * Sc[k + 1] + kk[1] * rr; Sc[k + 2] = dect * Sc[k + 2] + kk[2] * rr; Sc[k + 3] = dect * Sc[k + 3] + kk[3] * rr;
                o0 += Sc[k] * qq[0]; o1 += Sc[k + 1] * qq[1]; o2 += Sc[k + 2] * qq[2]; o3 += Sc[k + 3] * qq[3]; } }
        float ot = (o0 + o1) + (o2 + o3); ot += __shfl_xor(ot, 1);
        if (kh == 0) ov[t * 128 + v] = ot;
    }
    { float* so = p.out + O_GSS + (size_t)item * 16384 + (size_t)kh * 64 * 128 + v;
#pragma unroll
        for (int k = 0; k < 64; ++k) so[k * 128] = Sc[k]; }
    __syncthreads();
#pragma unroll
    for (int t = 0; t < 8; ++t) { const float ot = ov[t * 128 + v]; float s = kh ? 0.f : ot * ot;
#pragma unroll
        for (int oo = 32; oo >= 1; oo >>= 1) s += __shfl_xor(s, oo);
        if (lane == 0) red[64 + wv * 8 + t] = s; }
    __syncthreads();
    if (kh == 0) {
        const float gn = p.in[21][v];
#pragma unroll
        for (int t = 0; t < 8; ++t) { const float rs = rsqrtf((red[64 + t] + red[72 + t] + red[80 + t] + red[88 + t]) * (1.f / 128.f) + 1e-6f); const size_t grow = (size_t)8192 + b * 8 + t;
            const float z = bf2f(PROJ[grow * NPROJ + C_GZ + h * 128 + v]);
            YG[grow * 1024 + h * 128 + v] = f2bf(ov[t * 128 + v] * rs * gn * z); } }
}

template <bool F32SRC>
__device__ __forceinline__ void attn_stage(LAS unsigned char* lds, const void* src, int half) {
    const int tid = threadIdx.x;
    if (F32SRC) { const float* s = (const float*)src + (size_t)half * 128 * 1024; f32x4 a[8], b[8];
#pragma unroll
        for (int i = 0; i < 8; ++i) { const int q = tid + NTHR * i; const float* g = s + (size_t)(q >> 5) * 1024 + (q & 31) * 8; a[i] = *(const f32x4*)g; b[i] = *(const f32x4*)(g + 4); }
#pragma unroll
        for (int i = 0; i < 8; ++i) { const int q = tid + NTHR * i; u32x4 w; w.x = cvt_pk_bf16(a[i][0], a[i][1]); w.y = cvt_pk_bf16(a[i][2], a[i][3]); w.z = cvt_pk_bf16(b[i][0], b[i][1]); w.w = cvt_pk_bf16(b[i][2], b[i][3]);
            *(LAS u32x4*)(lds + (q >> 5) * 528 + (q & 31) * 16) = w; }
    } else { const bf16_t* s = (const bf16_t*)src + (size_t)half * 128 * 1024; u32x4 a[8];
#pragma unroll
        for (int i = 0; i < 8; ++i) { const int q = tid + NTHR * i; a[i] = *(const u32x4*)(s + (size_t)(q >> 5) * 1024 + (q & 31) * 8); }
#pragma unroll
        for (int i = 0; i < 8; ++i) { const int q = tid + NTHR * i; *(LAS u32x4*)(lds + (q >> 5) * 528 + (q & 31) * 16) = a[i]; }
    }
}
template <bool F32SRC>
__device__ __forceinline__ void attn_item(LAS unsigned char* lds, const bf16_t* Q, int nrows, const void* Kb, const void* Vb, bf16_t* O) {
    const int tid = threadIdx.x, lane = tid & 63, wid = __builtin_amdgcn_readfirstlane(tid >> 6), fr = lane & 15, fq = lane >> 4;
    const bool active = (16 * wid < nrows);
    LAS unsigned char* PSw = lds + 69632 + wid * 8448;
    __syncthreads();
    bf16x8 qf[8];
    { const int row = min(16 * wid + fr, nrows - 1);
#pragma unroll
        for (int k = 0; k < 8; ++k) qf[k] = *(const bf16x8*)(Q + (size_t)row * NPROJ + 32 * k + fq * 8); }
    f32x4 sacc[16];
#pragma unroll
    for (int i = 0; i < 16; ++i) sacc[i] = (f32x4){0.f, 0.f, 0.f, 0.f};
#pragma unroll
    for (int half = 0; half < 2; ++half) {
        attn_stage<F32SRC>(lds, Kb, half);
        __syncthreads();
        if (active) {
#pragma unroll
            for (int mt = 0; mt < 8; mt += 2) { bf16x8 kf[2][8];
#pragma unroll
                for (int e = 0; e < 2; ++e)
#pragma unroll
                    for (int k = 0; k < 8; ++k) kf[e][k] = *(const LAS bf16x8*)(lds + (16 * (mt + e) + fr) * 528 + (32 * k + fq * 8) * 2);
#pragma unroll
                for (int e = 0; e < 2; ++e)
#pragma unroll
                    for (int k = 0; k < 8; ++k) sacc[half * 8 + mt + e] = MFMA16(kf[e][k], qf[k], sacc[half * 8 + mt + e]); }
        }
        __syncthreads();
    }
    if (active) {
        float mx = -3.0e38f;
#pragma unroll
        for (int mt = 0; mt < 16; ++mt)
#pragma unroll
            for (int r = 0; r < 4; ++r) mx = fmaxf(mx, sacc[mt][r]);
        mx = fmaxf(mx, __shfl_xor(mx, 16)); mx = fmaxf(mx, __shfl_xor(mx, 32));
        float sum = 0.f;
#pragma unroll
        for (int mt = 0; mt < 16; ++mt)
#pragma unroll
            for (int r = 0; r < 4; ++r) { const float e = __expf((sacc[mt][r] - mx) * 0.0625f); sacc[mt][r] = e; sum += e; }
        sum += __shfl_xor(sum, 16); sum += __shfl_xor(sum, 32);
        const float inv = 1.f / sum;
#pragma unroll
        for (int mt = 0; mt < 16; ++mt) { u32x2 w; w.x = cvt_pk_bf16(sacc[mt][0] * inv, sacc[mt][1] * inv); w.y = cvt_pk_bf16(sacc[mt][2] * inv, sacc[mt][3] * inv);
            *(LAS u32x2*)(PSw + fr * 528 + (16 * mt + 4 * fq) * 2) = w; }
    }
    f32x4 oacc[16];
#pragma unroll
    for (int i = 0; i < 16; ++i) oacc[i] = (f32x4){0.f, 0.f, 0.f, 0.f};
#pragma unroll
    for (int half = 0; half < 2; ++half) {
        attn_stage<F32SRC>(lds, Vb, half);
        __syncthreads();
        if (active) {
#pragma unroll
            for (int k = 0; k < 4; ++k) { const bf16x8 pfrag = *(const LAS bf16x8*)(PSw + fr * 528 + (128 * half + 32 * k + fq * 8) * 2);
#pragma unroll
                for (int d0 = 0; d0 < 16; d0 += 8) { s16x4 lo[8], hi[8];
#pragma unroll
                    for (int e = 0; e < 8; ++e) { LAS unsigned char* va = lds + (32 * k + 8 * fq + (fr >> 2)) * 528 + (16 * (d0 + e) + 4 * (fr & 3)) * 2;
                        lo[e] = __builtin_amdgcn_ds_read_tr16_b64_v4i16((LAS s16x4*)va); hi[e] = __builtin_amdgcn_ds_read_tr16_b64_v4i16((LAS s16x4*)(va + 4 * 528)); }
#pragma unroll
                    for (int e = 0; e < 8; ++e) { bf16x8 vf; vf[0] = lo[e][0]; vf[1] = lo[e][1]; vf[2] = lo[e][2]; vf[3] = lo[e][3]; vf[4] = hi[e][0]; vf[5] = hi[e][1]; vf[6] = hi[e][2]; vf[7] = hi[e][3];
                        oacc[d0 + e] = MFMA16(vf, pfrag, oacc[d0 + e]); } } }
        }
        __syncthreads();
    }
    if (active && 16 * wid + fr < nrows) {
        bf16_t* op = O + (size_t)(16 * wid + fr) * 1024 + 4 * fq;
#pragma unroll
        for (int dt = 0; dt < 16; ++dt) { u32x2 w; w.x = cvt_pk_bf16(oacc[dt][0], oacc[dt][1]); w.y = cvt_pk_bf16(oacc[dt][2], oacc[dt][3]); *(u32x2*)(op + 16 * dt) = w; }
    }
}

__device__ __forceinline__ void conv_states(const P& p, int bid, int G) {
    const bf16_t* PROJ = (const bf16_t*)(p.ws + WS_PROJ);
    const int total = 12288 + 36864 + 393216 + 1179648;
    for (int i = bid * NTHR + threadIdx.x; i < total; i += G * NTHR) {
        int e = i; size_t oo; int bj, ch, col0, W; size_t rowbase; int T;
        if (e < 12288) { oo = O_RCP; W = 1024; col0 = C_RX; T = 2048; rowbase = 0; }
        else if ((e -= 12288) < 36864) { oo = O_GCP; W = 3072; col0 = C_GQ; T = 2048; rowbase = 0; }
        else if ((e -= 36864) < 393216) { oo = O_RCS; W = 1024; col0 = C_RX; T = 8; rowbase = 8192; }
        else { e -= 393216; oo = O_GCS; W = 3072; col0 = C_GQ; T = 8; rowbase = 8192; }
        bj = e / W; ch = e - bj * W; const int b = bj / 3, j = bj - b * 3;
        p.out[oo + e] = bf2f(PROJ[(rowbase + (size_t)b * T + (T - 3 + j)) * NPROJ + col0 + ch]);
    }
}


#ifndef DBG_CHECK
#define DBG_CHECK 1
#endif
__device__ __forceinline__ float blk_sum(LAS float* red, float v) {
    __syncthreads();
#pragma unroll
    for (int o = 32; o >= 1; o >>= 1) v += __shfl_xor(v, o);
    if ((threadIdx.x & 63) == 0) red[threadIdx.x >> 6] = v;
    __syncthreads();
    float t = 0.f;
#pragma unroll
    for (int i = 0; i < 8; ++i) t += red[i];
    return t;
}
__device__ __forceinline__ void dbg_flag(const P& p, unsigned id) { atomicMax((unsigned*)p.ws, id); }
__global__ void __launch_bounds__(NTHR) dbg_check_gemm1(P p) {
    __shared__ float red_s[8]; LAS float* red = (LAS float*)red_s; const int tid = threadIdx.x, bid = blockIdx.x;
    for (int s = bid; s < 1024; s += gridDim.x) {
        const int row = (s * 37 + 11) % 9216; const int oc = (int)(((long)s * 5303 + 7) % 13328);
        const int pc = oc < 6144 ? oc : (oc < 6160 ? 13312 + (oc - 6144) : oc - 16);
        const float* x = row < 8192 ? p.in[0] + (size_t)row * 2048 : p.in[1] + (size_t)(row - 8192) * 2048;
        float ss = 0.f, dot = 0.f;
        for (int k = tid; k < 2048; k += NTHR) { const float xv = x[k]; ss += xv * xv; dot += xv * p.in[9][k] * p.in[10][(size_t)k * 13328 + oc]; }
        ss = blk_sum(red, ss); dot = blk_sum(red, dot);
        float ref = dot * rsqrtf(ss * (1.f / 2048.f) + 1e-6f);
        const int pn = pc >> 8; const int act = (pn >= 4 && pn < 8) ? 1 : (pn >= 20 && pn < 24) ? 2 : (pn >= 28 && pn < 52) ? 3 : 0;
        float got;
        if (pc >= 13312) got = ((const float*)(p.ws + WS_GBA))[(size_t)row * 16 + (pc - 13312)];
        else { got = bf2f(((const bf16_t*)(p.ws + WS_PROJ))[(size_t)row * NPROJ + pc]); if (act) ref = actf(ref, act); }
        if (tid == 0 && !(fabsf(got - ref) <= 0.03f + 0.03f * fabsf(ref))) dbg_flag(p, 1u + (unsigned)(pn >= 52 ? 5 : pn >= 28 ? 4 : pn >= 24 ? 3 : pn >= 8 ? 2 : pn >= 4 ? 1 : 0));
    }
    for (int s = bid; s < 256; s += gridDim.x) {
        const int row = (s * 29 + 3) % 1024; const int oc = (s * 523 + 5) % 2048;
        const float* x = p.in[2] + (size_t)row * 2048;
        float ss = 0.f, dot = 0.f;
        for (int k = tid; k < 2048; k += NTHR) { const float xv = x[k]; ss += xv * xv; dot += xv * p.in[22][k] * p.in[23][(size_t)k * 2048 + oc]; }
        ss = blk_sum(red, ss); dot = blk_sum(red, dot);
        const float ref = dot * rsqrtf(ss * (1.f / 2048.f) + 1e-6f);
        const float got = oc < 1024 ? p.out[O_MK + (size_t)row * 1024 + oc] : p.out[O_MV + (size_t)row * 1024 + oc - 1024];
        if (tid == 0 && !(fabsf(got - ref) <= 0.03f + 0.03f * fabsf(ref))) dbg_flag(p, 10u);
    }
}

__global__ void dbg_scan_bf16(P p, size_t off, size_t n, float bound, unsigned id) {
    const bf16_t* q = (const bf16_t*)(p.ws + off); bool bad = false;
    for (size_t i = (size_t)blockIdx.x * blockDim.x + threadIdx.x; i < n; i += (size_t)gridDim.x * blockDim.x) { const float v = bf2f(q[i]); if (!(fabsf(v) <= bound)) bad = true; }
    if (bad) atomicMax((unsigned*)p.ws, id);
}
__global__ void dbg_scan_f32(P p, const float* q, size_t n, float lo, float hi, unsigned id) {
    bool bad = false;
    for (size_t i = (size_t)blockIdx.x * blockDim.x + threadIdx.x; i < n; i += (size_t)gridDim.x * blockDim.x) { const float v = q[i]; if (!(v >= lo && v <= hi)) bad = true; }
    if (bad) atomicMax((unsigned*)p.ws, id);
}
__global__ void dbg_scan_gp(P p, int suboff, int sublen, float bound, unsigned id) {
    bool bad = false;
    for (int item = blockIdx.x; item < 1024; item += gridDim.x) { const bf16_t* q = (const bf16_t*)(p.ws + WS_GP) + (size_t)item * 36864 + suboff;
        for (int i = threadIdx.x; i < sublen; i += blockDim.x) { const float v = bf2f(q[i]); if (!(fabsf(v) <= bound)) bad = true; } }
    if (bad) atomicMax((unsigned*)p.ws, id);
}
__global__ void dbg_scan2(P p, size_t base, size_t stride, int sublen, float bound, unsigned id_nan, unsigned id_big) {
    bool nan = false, big = false;
    for (int item = blockIdx.x; item < 1024; item += gridDim.x) { const bf16_t* q = (const bf16_t*)(p.ws + base) + (size_t)item * stride;
        for (int i = threadIdx.x; i < sublen; i += blockDim.x) { const float v = bf2f(q[i]); if (v != v) nan = true; else if (fabsf(v) > bound) big = true; } }
    if (nan) atomicMax((unsigned*)p.ws, id_nan); if (big) atomicMax((unsigned*)p.ws, id_big);
}
__global__ void dbg_scanbit(P p, size_t base, size_t stride, int sublen, float bound, unsigned bit) {
    bool bad = false;
    for (int item = blockIdx.x; item < 1024; item += gridDim.x) { const bf16_t* q = (const bf16_t*)(p.ws + base) + (size_t)item * stride;
        for (int i = threadIdx.x; i < sublen; i += blockDim.x) { const float v = bf2f(q[i]); if (!(fabsf(v) <= bound)) bad = true; } }
    if (bad) atomicOr((unsigned*)p.ws + 1, 1u << bit);
}
__global__ void dbg_report(P p) { const unsigned f = *(const unsigned*)p.ws, m = ((const unsigned*)p.ws)[1]; if (m) p.out[O_Y] = 1000.f * (float)(10u + m); else if (f) p.out[O_Y] = 1000.f * (float)f; }

__global__ void __launch_bounds__(NTHR, 2) mega(P p) {
    extern __shared__ __attribute__((aligned(16))) unsigned char lds_raw[];
    LAS unsigned char* lds = (LAS unsigned char*)lds_raw;
    cg::grid_group grid = cg::this_grid();
    const int G = gridDim.x, bid = blockIdx.x, tid = threadIdx.x;
    unsigned char* ws = p.ws;
#define PH(k) (p.ph_lo <= (k) && (k) < p.ph_hi)
#define SEAM(k) do { if (PH(k) && PH((k) + 1)) grid.sync(); } while (0)

    if (PH(0)) phase0(lds, p, bid, G);
    SEAM(0);

    if (PH(1)) {
        { pg8::Gemm g{(const bf16_t*)(ws + WS_XN), (const bf16_t*)(ws + WS_WIN), 9216, NPROJ, 2048, 0}; pg8::StaticOrder S; S.init(9216, NPROJ, G, bid);
          pg8::EpiProj E{(bf16_t*)(ws + WS_PROJ), (float*)(ws + WS_GBA)}; if (EN_GEMM) pg8::gemm_phase(lds, g, S, E); }
        { pg8::Gemm g{(const bf16_t*)(ws + WS_MEMN), (const bf16_t*)(ws + WS_WMKV), 1024, 2048, 2048, 0}; pg8::StaticOrder S; S.init(1024, 2048, G, G - 1 - bid);
          pg8::EpiMemKV E{p.out + O_MK, p.out + O_MV, (bf16_t*)(ws + WS_MKB), (bf16_t*)(ws + WS_MVB)}; if (EN_GEMM) pg8::gemm_phase(lds, g, S, E); }
    }
    SEAM(1);

    if (PH(2)) {
        for (int it = bid; it < 1024 + 512; it += G) {
            if (it < 1024) { if (EN_PREP) gdn_prep_item(lds, p, it); }
            else { const int k = it - 1024, b = k >> 2, h = k & 3;
                if (EN_ATTS) attn_item<true>(lds, (const bf16_t*)(ws + WS_PROJ) + (size_t)(8192 + b * 8) * NPROJ + C_MQ + h * 256, 8,
                                p.in[3] + (size_t)b * 262144 + h * 256, p.in[4] + (size_t)b * 262144 + h * 256,
                                (bf16_t*)(ws + WS_YCAT) + (size_t)2 * 9216 * 1024 + (size_t)(8192 + b * 8) * 1024 + h * 256); }
        }
        conv_states(p, bid, G);
    }
    SEAM(2);

    if (PH(3)) {
        const int NMISC = 256 + 512 + 256;
        if (bid < 32) { if (EN_SEQ && (p.roles & 1)) gdn_seq_item(lds, p, bid); } else if (bid < 160) { if (EN_RGP && (p.roles & 2)) rglru_item<true>(lds, p, bid - 32); }
        if (bid >= 160) {
            int tb = 0; const int b2 = bid - 160, g2 = G - 160;
            tconv(lds, p.in[24], 1024, 2048, (bf16_t*)(ws + WS_WUPS), 2048, nullptr, false, tb, b2, g2);
            tconv(lds, p.in[25], 1024, 2048, (bf16_t*)(ws + WS_WUPS) + (size_t)2048 * 1024, 2048, nullptr, false, tb, b2, g2);
            tconv(lds, p.in[26], 1024, 2048, (bf16_t*)(ws + WS_WUPS) + (size_t)2 * 2048 * 1024, 2048, nullptr, false, tb, b2, g2);
            tconv(lds, p.in[27], 2048, 2048, (bf16_t*)(ws + WS_WOUT), 2048, nullptr, false, tb, b2, g2);
            tconv(lds, p.in[29], 2048, 8192, (bf16_t*)(ws + WS_WUP), 8192, p.in[28], false, tb, b2, g2);
            tconv(lds, p.in[30], 8192, 2048, (bf16_t*)(ws + WS_WDN), 2048, nullptr, false, tb, b2, g2);
        }
        if (p.roles & 4) {
            LAS int* slot = (LAS int*)(lds + 137216);
            for (;;) {
                __syncthreads();
                if (tid == 0) *slot = (int)atomicAdd((unsigned*)ws + 16, 1u);
                __syncthreads();
                const int it = *slot;
                if (it >= NMISC) break;
                if (it < 256) { const int b = it >> 6, h = (it >> 4) & 3, t = it & 15; const size_t row0 = (size_t)b * 2048 + t * 128;
                    if (EN_ATTP) attn_item<false>(lds, (const bf16_t*)(ws + WS_PROJ) + row0 * NPROJ + C_MQ + h * 256, 128,
                                     (const bf16_t*)(ws + WS_MKB) + (size_t)b * 262144 + h * 256, (const bf16_t*)(ws + WS_MVB) + (size_t)b * 262144 + h * 256,
                                     (bf16_t*)(ws + WS_YCAT) + (size_t)2 * 9216 * 1024 + row0 * 1024 + h * 256); }
                else if (it < 768) { if (EN_GS) gdn_sample_pass(lds, p, it - 256); }
                else { if (EN_RGS) rglru_item<false>(lds, p, it - 768); }
            }
        }
    }
    SEAM(3);

    if (PH(4)) {
        pg8::Gemm g{(const bf16_t*)(ws + WS_YCAT), (const bf16_t*)(ws + WS_WUPS), 3 * 9216, 3 * 2048, 1024, 0}; pg8::TripleOrder S{G, bid};
        pg8::EpiMerge E{(const bf16_t*)(ws + WS_PROJ), (float*)(ws + WS_GP), (bf16_t*)(ws + WS_MERGED)}; if (EN_GEMM) pg8::gemm_phase(lds, g, S, E);
    }
    SEAM(4);

    if (PH(5)) {
        pg8::Gemm g{(const bf16_t*)(ws + WS_MERGED), (const bf16_t*)(ws + WS_WOUT), 9216, 2048, 2048, 0}; pg8::StaticOrder S; S.init(9216, 2048, G, bid);
        pg8::EpiOut E{p.in[0], p.in[1], p.out + O_Y, (bf16_t*)(ws + WS_XN), (float*)(ws + WS_SS1)}; if (EN_GEMM) pg8::gemm_phase(lds, g, S, E);
    }
    SEAM(5);

    if (PH(6)) {
        pg8::Gemm g{(const bf16_t*)(ws + WS_XN), (const bf16_t*)(ws + WS_WUP), 9216, 8192, 2048, 0}; pg8::StaticOrder S; S.init(9216, 8192, G, bid);
        pg8::EpiUp E{(const float*)(ws + WS_SS1), (bf16_t*)(ws + WS_PROJ)}; if (EN_GEMM) pg8::gemm_phase(lds, g, S, E);
    }
    SEAM(6);

    if (PH(7)) {
        { pg8::Gemm g{(const bf16_t*)(ws + WS_PROJ), (const bf16_t*)(ws + WS_WDN), 9216, 2048, 8192, 0}; pg8::DownMain S{G, bid};
          pg8::EpiDown E{p.out + O_Y, (const bf16_t*)(ws + WS_XN)}; if (EN_GEMM) pg8::gemm_phase(lds, g, S, E); }
        { pg8::Gemm g{(const bf16_t*)(ws + WS_PROJ), (const bf16_t*)(ws + WS_WDN), 9216, 2048, 8192, 16}; pg8::DownTail S{G, bid};
          pg8::EpiDownPart E{(float*)(ws + WS_GP)}; if (EN_GEMM) pg8::gemm_phase(lds, g, S, E); }
    }
    SEAM(7);

    if (PH(8)) {
        const int lane = tid & 63, wid = tid >> 6; const float* part = (const float*)(ws + WS_GP);
        for (int row = bid * 8 + wid; row < 9216; row += G * 8) { float* x = p.out + O_Y + (size_t)row * 2048; f32x4 v[8]; float ss = 0.f;
            if (row < 8192) {
#pragma unroll
                for (int i = 0; i < 8; ++i) { const int c = (i * 64 + lane) * 4; v[i] = *(const f32x4*)(x + c); }
            } else { const bf16_t* xb = (const bf16_t*)(ws + WS_XN) + (size_t)row * 2048;
#pragma unroll
                for (int i = 0; i < 8; ++i) { const u32x2 r = *(const u32x2*)(xb + (i * 64 + lane) * 4); v[i] = (f32x4){bf_lo(r.x), bf_hi(r.x), bf_lo(r.y), bf_hi(r.y)}; }
#pragma unroll 1
                for (int sl = 0; sl < 8; ++sl) { const float* pr = part + ((size_t)sl * 1024 + (row - 8192)) * 2048;
#pragma unroll
                    for (int i = 0; i < 8; ++i) v[i] += *(const f32x4*)(pr + (i * 64 + lane) * 4); } }
#pragma unroll
            for (int i = 0; i < 8; ++i) ss += v[i][0] * v[i][0] + v[i][1] * v[i][1] + v[i][2] * v[i][2] + v[i][3] * v[i][3];
#pragma unroll
            for (int o = 32; o >= 1; o >>= 1) ss += __shfl_xor(ss, o);
            const float rs = rsqrtf(ss * (1.f / 2048.f) + 1e-6f);
#pragma unroll
            for (int i = 0; i < 8; ++i) { const int c = (i * 64 + lane) * 4; *(f32x4*)(x + c) = v[i] * rs * *(const f32x4*)(p.in[31] + c); } }
    }
#undef PH
#undef SEAM
}

extern "C" void kernel_launch(void* const* d_in, const int* in_sizes, int n_in, void* d_out, int out_size, void* d_ws, size_t ws_size, hipStream_t stream) {
    static int grid = 0;
    if (grid == 0) {
        if (n_in != 32 || out_size != 40030208 || ws_size < WS_END) { fprintf(stderr, "kernel_launch: unexpected shapes (n_in %d, out %d, ws %zu; need ws >= %zu)\n", n_in, out_size, ws_size, (size_t)WS_END); grid = -1; return; }
        int dev = 0, cus = 0, per_cu = 0;
        hipGetDevice(&dev); hipDeviceGetAttribute(&cus, hipDeviceAttributeMultiprocessorCount, dev);
        if (hipFuncSetAttribute((const void*)mega, hipFuncAttributeMaxDynamicSharedMemorySize, LDS_BYTES) != hipSuccess) { fprintf(stderr, "kernel_launch: hipFuncSetAttribute failed\n"); grid = -1; return; }
        if (hipOccupancyMaxActiveBlocksPerMultiprocessor(&per_cu, (const void*)mega, NTHR, LDS_BYTES) != hipSuccess || per_cu < 1) { fprintf(stderr, "kernel_launch: occupancy query says %d\n", per_cu); (void)hipGetLastError(); per_cu = 1; }
        grid = cus * 1;
        if (grid < 192) { fprintf(stderr, "kernel_launch: needs >= 192 CUs (got %d)\n", grid); grid = -1; return; }
    }
    if (grid < 0) return;
    P p{};
    for (int i = 0; i < 32; ++i) p.in[i] = (const float*)d_in[i];
    p.out = (float*)d_out; p.ws = (unsigned char*)d_ws; p.roles = 7;
#if defined(PROBE_SEGS)
    { static const int segs[][2] = PROBE_SEGS; const int nseg = (int)(sizeof(segs) / sizeof(segs[0]));
      for (int si = 0; si < nseg; ++si) { P q = p; q.ph_lo = segs[si][0]; q.ph_hi = segs[si][1]; if (si == 1) q.roles = PROBE_ROLES; void* qa[] = {&q};
          if (q.ph_hi - q.ph_lo > 1) (void)hipLaunchCooperativeKernel((const void*)mega, dim3(grid), dim3(NTHR), qa, LDS_BYTES, stream);
          else hipLaunchKernelGGL(mega, dim3(grid), dim3(NTHR), LDS_BYTES, stream, q); } }
#elif ONE_LAUNCH
    p.ph_lo = 0; p.ph_hi = DBG_PH_HI;
    void* args[] = {&p};
    hipError_t e = hipLaunchCooperativeKernel((const void*)mega, dim3(grid), dim3(NTHR), args, LDS_BYTES, stream);
    if (e != hipSuccess) fprintf(stderr, "cooperative launch failed: %s (grid %d)\n", hipGetErrorString(e), grid);
#else
    (void)hipMemsetAsync(d_ws, 0, 256, stream);
    for (int k = 0; k < DBG_PH_HI; ++k) { p.ph_lo = k; p.ph_hi = k + 1; hipLaunchKernelGGL(mega, dim3(grid), dim3(NTHR), LDS_BYTES, stream, p);
        if (k == 1) hipLaunchKernelGGL(dbg_check_gemm1, dim3(256), dim3(NTHR), 0, stream, p);
        if (k == 2) { hipLaunchKernelGGL(dbg_scan_f32, dim3(4), dim3(256), 0, stream, p, (const float*)((unsigned char*)d_ws + WS_DEC), (size_t)1024, 0.f, 1.f, 21u);
            hipLaunchKernelGGL(dbg_scanbit, dim3(256), dim3(256), 0, stream, p, (size_t)WS_GP, (size_t)36864, 8192, 100.f, 0u);
            hipLaunchKernelGGL(dbg_scanbit, dim3(256), dim3(256), 0, stream, p, (size_t)WS_GP + 16384 * 2, (size_t)36864, 8192, 100.f, 1u); }
    }
    hipLaunchKernelGGL(dbg_report, dim3(1), dim3(1), 0, stream, p);
#endif
}
```

```cpp
#include <hip/hip_runtime.h>
#include <hip/hip_cooperative_groups.h>
#include <cstdio>
namespace cg = cooperative_groups;

#ifndef ONE_LAUNCH
#define ONE_LAUNCH 1
#endif
#ifndef DBG_DUMP
#define DBG_DUMP 0
#endif
#ifndef DBG_SEQ_SUM
#define DBG_SEQ_SUM 0
#endif
#ifndef DBG_PH_HI
#define DBG_PH_HI 9
#endif


#ifndef EN_ALL
#define EN_ALL 1
#endif
#ifndef EN_PREP
#define EN_PREP EN_ALL
#endif
#ifndef EN_ATTS
#define EN_ATTS EN_ALL
#endif
#ifndef EN_SEQ
#define EN_SEQ EN_ALL
#endif
#ifndef EN_RGP
#define EN_RGP EN_ALL
#endif
#ifndef EN_ATTP
#define EN_ATTP EN_ALL
#endif
#ifndef EN_GS
#define EN_GS EN_ALL
#endif
#ifndef EN_RGS
#define EN_RGS EN_ALL
#endif
#ifndef EN_GEMM
#define EN_GEMM EN_ALL
#endif
#define LAS __attribute__((address_space(3)))
typedef unsigned short bf16_t;
typedef short bf16x8 __attribute__((ext_vector_type(8)));
typedef short s16x4 __attribute__((ext_vector_type(4)));
typedef float f32x4 __attribute__((ext_vector_type(4)));
typedef unsigned u32x4 __attribute__((ext_vector_type(4)));
typedef unsigned u32x2 __attribute__((ext_vector_type(2)));

constexpr int NPROJ = 13568;
constexpr int C_RX = 0, C_RG = 1024, C_GQ = 2048, C_GZ = 5120, C_MQ = 6144, C_MG = 7168;
constexpr int NTHR = 512;
constexpr int LDS_BYTES = 137280;
constexpr int NPHASE = 9;

constexpr size_t O_Y = 0, O_MK = 18874368, O_MV = 19922944, O_RCP = 20971520, O_RHP = 20983808, O_GCP = 20987904, O_GSP = 21024768,
                 O_RCS = 21549056, O_RHS = 21942272, O_GCS = 22073344, O_GSS = 23252992;
constexpr size_t WS_SS1 = 4096, WS_SS2 = 40960, WS_DEC = 77824, WS_GBA = 81920, WS_WIN = 1048576, WS_WMKV = 56623104, WS_WUPS = 65011712,
                 WS_WOUT = 77594624, WS_WUP = 85983232, WS_WDN = 119537664, WS_WRG = 153092096, WS_XN = 153616384, WS_MEMN = 191365120,
                 WS_MKB = 195559424, WS_MVB = 197656576, WS_YCAT = 199753728, WS_MERGED = 256376832, WS_GP = 294125568, WS_PROJ = 369623040,
                 WS_END = 619708416;

struct P { const float* in[32]; float* out; unsigned char* ws; int ph_lo, ph_hi, roles, pad; };

typedef __bf16 bf16v2_t __attribute__((ext_vector_type(2)));
typedef float f32v2_t __attribute__((ext_vector_type(2)));
__device__ __forceinline__ unsigned cvt_pk_bf16(float lo, float hi) { const f32v2_t v = {lo, hi}; const bf16v2_t b = __builtin_convertvector(v, bf16v2_t); return __builtin_bit_cast(unsigned, b); }
__device__ __forceinline__ bf16_t f2bf(float f) { return (bf16_t)(cvt_pk_bf16(f, 0.f) & 0xffffu); }
__device__ __forceinline__ float bf2f(bf16_t b) { return __uint_as_float(((unsigned)b) << 16); }
__device__ __forceinline__ float bf_lo(unsigned u) { return __uint_as_float(u << 16); }
__device__ __forceinline__ float bf_hi(unsigned u) { return __uint_as_float(u & 0xffff0000u); }
__device__ __forceinline__ float sigm(float x) { return __builtin_amdgcn_rcpf(1.f + __expf(-x)); }
__device__ __forceinline__ float siluf(float x) { return x * sigm(x); }
__device__ __forceinline__ float softplusf(float x) { return fmaxf(x, 0.f) + log1pf(__expf(-fabsf(x))); }
__device__ __forceinline__ float actf(float x, int act) {
    if (act == 1) { const float t = 1.5957691216f * (x + 0.044715f * x * x * x); return x * sigm(t); }
    if (act == 2) return x * sigm(x);
    return sigm(x);
}
__device__ __forceinline__ float DBGFIN(float x) { return x; }
#define LDS_BAR() do { asm volatile("s_waitcnt lgkmcnt(0)" ::: "memory"); __builtin_amdgcn_s_barrier(); asm volatile("" ::: "memory"); } while (0)
#define MFMA16(a, b, c) __builtin_amdgcn_mfma_f32_16x16x32_bf16((a), (b), (c), 0, 0, 0)

namespace pg8 {
constexpr int BM = 256, BK = 64, HALF = 128, HTB = HALF * BK * 2, STAGE_BYTES = 8 * HTB, NXCD = 8, WGM = 8;
__host__ __device__ __forceinline__ int lds_byte(int r, int c) { const int st = (r >> 4) * 2 + (c >> 5), rr = r & 15, cc = c & 31, ob = rr * 64 + cc * 2; return st * 1024 + (ob ^ (((ob >> 9) & 1) << 5)); }
__host__ __device__ __forceinline__ void stage_rc(int b, int& R, int& C) { const int st = b / 1024, sb = b % 1024, swz = sb ^ (((sb >> 9) & 1) << 5); R = (st >> 1) * 16 + swz / 64; C = (st & 1) * 32 + (swz % 64) / 2; }
__host__ __device__ __forceinline__ int perm32(int rho) { const int n = rho >> 4, i = rho & 15; return 8 * (i >> 2) + 4 * n + (i & 3); }
struct Unit { int pm, pn, k0; };
struct Gemm { const bf16_t* A; const bf16_t* Bt; int M, N, K; int ntu; };
struct StaticOrder {
    int nM, nN, nwg, G, c;
    __device__ void init(int M, int N, int G_, int c_) { nM = M / BM; nN = N / BM; nwg = nM * nN; G = G_; c = c_; }
    __device__ bool next(int i, Unit& u) const {
        const long L = (long)i * G + c; if (L >= nwg) return false;
        int wgid = (int)L; { const int q = nwg / NXCD, r = nwg % NXCD, xcd = wgid % NXCD, off = wgid / NXCD; wgid = (xcd < r ? xcd * (q + 1) : r * (q + 1) + (xcd - r) * q) + off; }
        const int nig = WGM * nN, gid = wgid / nig, fm = gid * WGM, gsz = (nM - fm) < WGM ? (nM - fm) : WGM;
        u.pm = fm + ((wgid % nig) % gsz); u.pn = (wgid % nig) / gsz; u.k0 = 0; return true;
    }
};
struct TripleOrder {
    int G, c;
    __device__ bool next(int i, Unit& u) const {
        StaticOrder S0; S0.init(9216, 2048, G, c); Unit t; if (!S0.next(i / 3, t)) return false;
        const int br = i % 3; u.pm = br * 36 + t.pm; u.pn = br * 8 + t.pn; u.k0 = 0; return true;
    }
};

struct DownMain { int G, c; __device__ bool next(int i, Unit& u) const { const int L = i * G + c; if (L >= 256) return false; const int x = L & 7, j = L >> 3;
        u.pm = (x >> 1) * 8 + (j & 7); u.pn = (x & 1) * 4 + (j >> 3); u.k0 = 0; return true; } };
struct DownTail { int G, c; __device__ bool next(int i, Unit& u) const { const int L = i * G + c; if (L >= 256) return false; const int t = L >> 3; u.pm = 32 + (t >> 3); u.pn = t & 7; u.k0 = (L & 7) * 16; return true; } };

template <class Epi, class Sched>
__device__ __forceinline__ void gemm_phase(LAS unsigned char* lds, const Gemm g, const Sched& S, const Epi& E) {
    const int tid = threadIdx.x, wid = __builtin_amdgcn_readfirstlane(tid >> 6), lane = tid & 63, wr = wid >> 2, wc = wid & 3, fr = lane & 15, fq = lane >> 4;
    const int K = g.K, nt = g.ntu ? g.ntu : K / BK;
    unsigned voffA[2], voffB[2];
#pragma unroll
    for (int i = 0; i < 2; ++i) { int R, C; stage_rc(tid * 16 + i * 8192, R, C); const int Rb = Epi::PERM ? ((R & ~31) + perm32(R & 31)) : R;
        voffA[i] = (unsigned)(R * K + C) * 2u; voffB[i] = (unsigned)(Rb * K + C) * 2u; }
    const size_t kstep = (size_t)(BK * 2);
    const size_t hstep = (size_t)HALF * K * 2;
    const size_t tstep = 2 * hstep;
    const unsigned ldsw = (unsigned)wid * 1024u;
    const int aoff = lds_byte(wr * 64 + fr, fq * 8), boff = lds_byte(wc * 32 + fr, fq * 8);
#define PG8_SA(b, h) (((b) * 2 + (h)) * HTB)
#define PG8_SB(b, h) ((4 + (b) * 2 + (h)) * HTB)
#define PG8_STAGE(bufoff, gbase, voff) do { _Pragma("unroll") for (int _i = 0; _i < 2; ++_i) \
        __builtin_amdgcn_global_load_lds((const unsigned*)((const char*)(gbase) + (voff)[_i]), (LAS unsigned*)(lds + (bufoff) + ldsw + _i * 8192), 16, 0, 0); } while (0)
#define PG8_LDA(dst, b, h) do { _Pragma("unroll") for (int m = 0; m < 4; ++m) _Pragma("unroll") for (int k = 0; k < 2; ++k) dst[m][k] = *(const LAS bf16x8*)(lds + PG8_SA(b, h) + aoff + m * 2048 + k * 1024); } while (0)
#define PG8_LDB(dst, b, h) do { _Pragma("unroll") for (int n = 0; n < 2; ++n) _Pragma("unroll") for (int k = 0; k < 2; ++k) dst[n][k] = *(const LAS bf16x8*)(lds + PG8_SB(b, h) + boff + n * 2048 + k * 1024); } while (0)
#define PG8_MMA(ai, bj, At, Bt) do { __builtin_amdgcn_s_setprio(1); _Pragma("unroll") for (int m = 0; m < 4; ++m) _Pragma("unroll") for (int n = 0; n < 2; ++n) _Pragma("unroll") for (int k = 0; k < 2; ++k) \
        acc[ai][bj][m][n] = __builtin_amdgcn_mfma_f32_16x16x32_bf16(Bt[n][k], At[m][k], acc[ai][bj][m][n], 0, 0, 0); __builtin_amdgcn_s_setprio(0); } while (0)
#define PG8_WAIT_V(n) asm volatile("s_waitcnt vmcnt(" #n ")" ::: "memory")
#define PG8_WAIT_L(n) asm volatile("s_waitcnt lgkmcnt(" #n ")" ::: "memory")
#define PG8_BAR __builtin_amdgcn_s_barrier()
#define PG8_SCHED __builtin_amdgcn_sched_barrier(0)
    Unit cur, nxt; int ui = 0;
    if (!S.next(0, cur)) return;
    f32x4 acc[2][2][4][2];
#pragma unroll
    for (int a = 0; a < 2; ++a)
#pragma unroll
        for (int b = 0; b < 2; ++b)
#pragma unroll
            for (int m = 0; m < 4; ++m)
#pragma unroll
                for (int n = 0; n < 2; ++n) acc[a][b][m][n] = (f32x4){0.f, 0.f, 0.f, 0.f};
    bf16x8 At[4][2], B0[2][2], B1[2][2];
    const char* cA = (const char*)g.A + (size_t)cur.pm * tstep + (size_t)cur.k0 * (BK * 2); const char* cB = (const char*)g.Bt + (size_t)cur.pn * tstep + (size_t)cur.k0 * (BK * 2);
    PG8_STAGE(PG8_SB(0, 0), cB, voffB); PG8_STAGE(PG8_SA(0, 0), cA, voffA); PG8_STAGE(PG8_SB(0, 1), cB + hstep, voffB); PG8_STAGE(PG8_SA(0, 1), cA + hstep, voffA);
    if (wr == 1) PG8_BAR;
    PG8_WAIT_V(4); PG8_BAR;
    PG8_STAGE(PG8_SB(1, 0), cB + kstep, voffB); PG8_STAGE(PG8_SA(1, 0), cA + kstep, voffA); PG8_STAGE(PG8_SB(1, 1), cB + hstep + kstep, voffB);
    PG8_WAIT_V(6); PG8_BAR;
    for (;;) {
        const bool has_next = S.next(ui + 1, nxt);
        const char* nA = has_next ? (const char*)g.A + (size_t)nxt.pm * tstep + (size_t)nxt.k0 * (BK * 2) : cA; const char* nB = has_next ? (const char*)g.Bt + (size_t)nxt.pn * tstep + (size_t)nxt.k0 * (BK * 2) : cB;
        for (int t = 0; t < nt; t += 2) {
            const bool last = (t == nt - 2);
            const char* a1 = cA + (size_t)(t + 1) * kstep;
            const char* a2 = last ? nA : cA + (size_t)(t + 2) * kstep; const char* b2 = last ? nB : cB + (size_t)(t + 2) * kstep;
            const char* a3 = a2 + kstep; const char* b3 = b2 + kstep;
            PG8_LDB(B0, 0, 0); PG8_SCHED; PG8_LDA(At, 0, 0); PG8_STAGE(PG8_SA(1, 1), a1 + hstep, voffA);
            PG8_WAIT_L(8); PG8_BAR; PG8_WAIT_L(0); PG8_MMA(0, 0, At, B0); PG8_BAR; PG8_SCHED;
            PG8_LDB(B1, 0, 1); PG8_STAGE(PG8_SB(0, 0), b2, voffB);
            PG8_BAR; PG8_WAIT_L(0); PG8_MMA(0, 1, At, B1); PG8_BAR;
            PG8_LDA(At, 0, 1); PG8_STAGE(PG8_SA(0, 0), a2, voffA);
            PG8_BAR; PG8_WAIT_L(0); PG8_MMA(1, 0, At, B0); PG8_BAR; PG8_SCHED;
            PG8_STAGE(PG8_SB(0, 1), b2 + hstep, voffB);
            PG8_WAIT_V(6); PG8_BAR; PG8_MMA(1, 1, At, B1); PG8_BAR;
            PG8_LDB(B0, 1, 0); PG8_SCHED; PG8_LDA(At, 1, 0); PG8_STAGE(PG8_SA(0, 1), a2 + hstep, voffA);
            PG8_WAIT_L(8); PG8_BAR; PG8_WAIT_L(0); PG8_MMA(0, 0, At, B0); PG8_BAR; PG8_SCHED;
            PG8_LDB(B1, 1, 1); PG8_STAGE(PG8_SB(1, 0), b3, voffB);
            PG8_BAR; PG8_WAIT_L(0); PG8_MMA(0, 1, At, B1); PG8_BAR;
            PG8_LDA(At, 1, 1); PG8_STAGE(PG8_SA(1, 0), a3, voffA);
            PG8_BAR; PG8_WAIT_L(0); PG8_MMA(1, 0, At, B0); PG8_BAR; PG8_SCHED;
            PG8_STAGE(PG8_SB(1, 1), b3 + hstep, voffB);
            PG8_WAIT_V(6); PG8_BAR; PG8_MMA(1, 1, At, B1); PG8_BAR;
        }
        E(acc, cur, wr, wc, fr, fq);
        if (!has_next) break;
#pragma unroll
        for (int a = 0; a < 2; ++a)
#pragma unroll
            for (int b = 0; b < 2; ++b)
#pragma unroll
                for (int m = 0; m < 4; ++m)
#pragma unroll
                    for (int n = 0; n < 2; ++n) acc[a][b][m][n] = (f32x4){0.f, 0.f, 0.f, 0.f};
        cur = nxt; cA = nA; cB = nB; ++ui;
    }
    PG8_WAIT_V(0);
    if (wr == 0) PG8_BAR;
    PG8_BAR;
#undef PG8_SA
#undef PG8_SB
#undef PG8_STAGE
#undef PG8_LDA
#undef PG8_LDB
#undef PG8_MMA
#undef PG8_WAIT_V
#undef PG8_WAIT_L
#undef PG8_BAR
#undef PG8_SCHED
}

typedef f32x4 Acc[2][2][4][2];

struct EpiProj {
    static constexpr bool PERM = true;
    bf16_t* O; float* gba;
    __device__ __forceinline__ void operator()(const Acc& acc, const Unit& u, int wr, int wc, int fr, int fq) const {
        const int row0 = u.pm * BM + wr * 64 + fr, col0 = u.pn * BM + wc * 32 + 8 * fq;
        const int pn = u.pn; const int act = (pn >= 4 && pn < 8) ? 1 : (pn >= 20 && pn < 24) ? 2 : (pn >= 28 && pn < 52) ? 3 : 0;
#pragma unroll
        for (int ai = 0; ai < 2; ++ai)
#pragma unroll
            for (int m = 0; m < 4; ++m) { bf16_t* rowp = O + (size_t)(row0 + ai * HALF + m * 16) * NPROJ + col0;
#pragma unroll
                for (int bj = 0; bj < 2; ++bj) { f32x4 v0 = acc[ai][bj][m][0], v1 = acc[ai][bj][m][1];
                    if (act) {
#pragma unroll
                        for (int j = 0; j < 4; ++j) { v0[j] = actf(v0[j], act); v1[j] = actf(v1[j], act); } }
                    u32x4 w; w.x = cvt_pk_bf16(v0[0], v0[1]); w.y = cvt_pk_bf16(v0[2], v0[3]); w.z = cvt_pk_bf16(v1[0], v1[1]); w.w = cvt_pk_bf16(v1[2], v1[3]);
                    *(u32x4*)(rowp + bj * HALF) = w; } }
        if (pn == 52 && wc == 0 && fq < 2) {
#pragma unroll
            for (int ai = 0; ai < 2; ++ai)
#pragma unroll
                for (int m = 0; m < 4; ++m) { float* gp = gba + (size_t)(row0 + ai * HALF + m * 16) * 16 + 8 * fq;
                    *(f32x4*)gp = acc[ai][0][m][0]; *(f32x4*)(gp + 4) = acc[ai][0][m][1]; } }
    }
};
struct EpiMemKV {
    static constexpr bool PERM = true;
    float* outk; float* outv; bf16_t* kb; bf16_t* vb;
    __device__ __forceinline__ void operator()(const Acc& acc, const Unit& u, int wr, int wc, int fr, int fq) const {
        const int row0 = u.pm * BM + wr * 64 + fr; const bool isv = u.pn >= 4; const int col0 = (u.pn & 3) * BM + wc * 32 + 8 * fq;
        float* of = isv ? outv : outk; bf16_t* ob = isv ? vb : kb;
#pragma unroll
        for (int ai = 0; ai < 2; ++ai)
#pragma unroll
            for (int m = 0; m < 4; ++m) { const size_t ro = (size_t)(row0 + ai * HALF + m * 16) * 1024 + col0;
#pragma unroll
                for (int bj = 0; bj < 2; ++bj) { const f32x4 v0 = acc[ai][bj][m][0], v1 = acc[ai][bj][m][1];
                    *(f32x4*)(of + ro + bj * HALF) = v0; *(f32x4*)(of + ro + bj * HALF + 4) = v1;
                    u32x4 w; w.x = cvt_pk_bf16(v0[0], v0[1]); w.y = cvt_pk_bf16(v0[2], v0[3]); w.z = cvt_pk_bf16(v1[0], v1[1]); w.w = cvt_pk_bf16(v1[2], v1[3]);
                    *(u32x4*)(ob + ro + bj * HALF) = w; } }
    }
};
struct EpiMerge {
    static constexpr bool PERM = true;
    const bf16_t* proj; float* mf; bf16_t* merged;
    __device__ __forceinline__ void operator()(const Acc& acc, const Unit& u, int wr, int wc, int fr, int fq) const {
        const int br = u.pm / 36, pm = u.pm - br * 36, pn = u.pn & 7;
        const int row0 = pm * BM + wr * 64 + fr, col0 = pn * BM + wc * 32 + 8 * fq;
#pragma unroll
        for (int ai = 0; ai < 2; ++ai)
#pragma unroll
            for (int m = 0; m < 4; ++m) { const size_t row = (size_t)(row0 + ai * HALF + m * 16);
#pragma unroll
                for (int bj = 0; bj < 2; ++bj) { const int col = col0 + bj * HALF;
                    const u32x4 gw = *(const u32x4*)(proj + row * NPROJ + C_MG + br * 2048 + col);
                    f32x4 v0 = acc[ai][bj][m][0], v1 = acc[ai][bj][m][1];
                    v0[0] *= bf_lo(gw.x); v0[1] *= bf_hi(gw.x); v0[2] *= bf_lo(gw.y); v0[3] *= bf_hi(gw.y);
                    v1[0] *= bf_lo(gw.z); v1[1] *= bf_hi(gw.z); v1[2] *= bf_lo(gw.w); v1[3] *= bf_hi(gw.w);
                    bf16_t* mp = merged + row * 2048 + col;
                    if (br > 0) { const u32x4 pv = *(const u32x4*)mp; v0[0] += bf_lo(pv.x); v0[1] += bf_hi(pv.x); v0[2] += bf_lo(pv.y); v0[3] += bf_hi(pv.y);
                        v1[0] += bf_lo(pv.z); v1[1] += bf_hi(pv.z); v1[2] += bf_lo(pv.w); v1[3] += bf_hi(pv.w); }
                    { u32x4 w; w.x = cvt_pk_bf16(v0[0], v0[1]); w.y = cvt_pk_bf16(v0[2], v0[3]); w.z = cvt_pk_bf16(v1[0], v1[1]); w.w = cvt_pk_bf16(v1[2], v1[3]);
                        *(u32x4*)mp = w; } }
                asm volatile("" ::: "memory"); }
    }
};
struct EpiOut {
    static constexpr bool PERM = true;
    const float* xp; const float* xs; float* x1; bf16_t* x1b; float* ss;
    __device__ __forceinline__ void operator()(const Acc& acc, const Unit& u, int wr, int wc, int fr, int fq) const {
        const int row0 = u.pm * BM + wr * 64 + fr, col0 = u.pn * BM + wc * 32 + 8 * fq;
        const float* xb = (u.pm < 32) ? xp : xs - (size_t)8192 * 2048;
#pragma unroll
        for (int ai = 0; ai < 2; ++ai)
#pragma unroll
            for (int m = 0; m < 4; ++m) { const size_t row = (size_t)(row0 + ai * HALF + m * 16); float s = 0.f;
#pragma unroll
                for (int bj = 0; bj < 2; ++bj) { const size_t o = row * 2048 + col0 + bj * HALF;
                    const f32x4 v0 = acc[ai][bj][m][0] + *(const f32x4*)(xb + o), v1 = acc[ai][bj][m][1] + *(const f32x4*)(xb + o + 4);
                    s += v0[0] * v0[0] + v0[1] * v0[1] + v0[2] * v0[2] + v0[3] * v0[3] + v1[0] * v1[0] + v1[1] * v1[1] + v1[2] * v1[2] + v1[3] * v1[3];
                    u32x4 w; w.x = cvt_pk_bf16(v0[0], v0[1]); w.y = cvt_pk_bf16(v0[2], v0[3]); w.z = cvt_pk_bf16(v1[0], v1[1]); w.w = cvt_pk_bf16(v1[2], v1[3]);
                    *(u32x4*)(x1b + o) = w; }
                s += __shfl_xor(s, 16); s += __shfl_xor(s, 32);
                if (fq == 0) atomicAdd(ss + row, s); }
    }
};
struct EpiUp {
    static constexpr bool PERM = true;
    const float* ss; bf16_t* hid;
    __device__ __forceinline__ void operator()(const Acc& acc, const Unit& u, int wr, int wc, int fr, int fq) const {
        const int row0 = u.pm * BM + wr * 64 + fr, col0 = u.pn * BM + wc * 32 + 8 * fq;
#pragma unroll
        for (int ai = 0; ai < 2; ++ai)
#pragma unroll
            for (int m = 0; m < 4; ++m) { const size_t row = (size_t)(row0 + ai * HALF + m * 16); const float rs = rsqrtf(ss[row] * (1.f / 2048.f) + 1e-6f);
#pragma unroll
                for (int bj = 0; bj < 2; ++bj) { f32x4 v0 = acc[ai][bj][m][0] * rs, v1 = acc[ai][bj][m][1] * rs;
#pragma unroll
                    for (int j = 0; j < 4; ++j) { const float a = fmaxf(v0[j], 0.f), b = fmaxf(v1[j], 0.f); v0[j] = a * a; v1[j] = b * b; }
                    u32x4 w; w.x = cvt_pk_bf16(v0[0], v0[1]); w.y = cvt_pk_bf16(v0[2], v0[3]); w.z = cvt_pk_bf16(v1[0], v1[1]); w.w = cvt_pk_bf16(v1[2], v1[3]);
                    *(u32x4*)(hid + row * 8192 + col0 + bj * HALF) = w; } }
    }
};
struct EpiDown {
    static constexpr bool PERM = false;
    float* x; const bf16_t* x1b;
    __device__ __forceinline__ void operator()(const Acc& acc, const Unit& u, int wr, int wc, int fr, int fq) const {
        const int row0 = u.pm * BM + wr * 64 + fr, col0 = u.pn * BM + wc * 32 + 4 * fq;
#pragma unroll
        for (int ai = 0; ai < 2; ++ai)
#pragma unroll
            for (int m = 0; m < 4; ++m) { const size_t ro = (size_t)(row0 + ai * HALF + m * 16) * 2048 + col0;
#pragma unroll
                for (int bj = 0; bj < 2; ++bj)
#pragma unroll
                    for (int n = 0; n < 2; ++n) { const size_t o = ro + bj * HALF + n * 16; const u32x2 r = *(const u32x2*)(x1b + o);
                        f32x4 v = acc[ai][bj][m][n]; v[0] += bf_lo(r.x); v[1] += bf_hi(r.x); v[2] += bf_lo(r.y); v[3] += bf_hi(r.y); *(f32x4*)(x + o) = v; } }
    }
};
struct EpiDownPart {
    static constexpr bool PERM = false;
    bf16_t* part;
    __device__ __forceinline__ void operator()(const Acc& acc, const Unit& u, int wr, int wc, int fr, int fq) const {
        const int row0 = (u.pm - 32) * BM + wr * 64 + fr, col0 = u.pn * BM + wc * 32 + 4 * fq; bf16_t* pb = part + (size_t)(u.k0 >> 4) * 1024 * 2048;
#pragma unroll
        for (int ai = 0; ai < 2; ++ai)
#pragma unroll
            for (int m = 0; m < 4; ++m) { bf16_t* rowp = pb + (size_t)(row0 + ai * HALF + m * 16) * 2048 + col0;
#pragma unroll
                for (int bj = 0; bj < 2; ++bj)
#pragma unroll
                    for (int n = 0; n < 2; ++n) { const f32x4 v = acc[ai][bj][m][n]; u32x2 w; w.x = cvt_pk_bf16(v[0], v[1]); w.y = cvt_pk_bf16(v[2], v[3]); *(u32x2*)(rowp + bj * HALF + n * 16) = w; } }
    }
};
}

__device__ __forceinline__ int win_map(int nd) { return nd < 6144 ? nd : (nd < 13312 ? nd + 16 : (nd < 13328 ? nd - 13312 + 6144 : -1)); }
__device__ __forceinline__ void tconv_tile(LAS float* T, const float* __restrict__ src, int K, int Nsrc, bf16_t* __restrict__ dst,
                                           const float* __restrict__ kscale, bool winmap, int t) {
    const int lane = threadIdx.x & 63; const int ntk = K / 64;
    const int tk = t % ntk, tn = t / ntk, k0 = tk * 64, n0 = tn * 64;
    f32x4 v[16];
#pragma unroll
    for (int i = 0; i < 16; ++i) { const int q = lane + 64 * i, kr = q >> 4, c4 = q & 15; const int nd = n0 + c4 * 4; const int ns = winmap ? win_map(nd) : nd;
        v[i] = (f32x4){0.f, 0.f, 0.f, 0.f};
        if (ns >= 0) v[i] = *(const f32x4*)(src + (size_t)(k0 + kr) * Nsrc + ns);
        if (kscale) v[i] *= kscale[k0 + kr]; }
#pragma unroll
    for (int i = 0; i < 16; ++i) { const int q = lane + 64 * i, kr = q >> 4, c4 = q & 15; LAS float* tp = T + kr * 65 + c4 * 4; tp[0] = v[i][0]; tp[1] = v[i][1]; tp[2] = v[i][2]; tp[3] = v[i][3]; }
    const int nl = lane >> 3, kg = lane & 7;
#pragma unroll
    for (int g = 0; g < 8; ++g) { const int nn = g * 8 + nl; float e[8];
#pragma unroll
        for (int j = 0; j < 8; ++j) e[j] = T[(kg * 8 + j) * 65 + nn];
        u32x4 w; w.x = cvt_pk_bf16(e[0], e[1]); w.y = cvt_pk_bf16(e[2], e[3]); w.z = cvt_pk_bf16(e[4], e[5]); w.w = cvt_pk_bf16(e[6], e[7]);
        *(u32x4*)(dst + (size_t)(n0 + nn) * K + k0 + kg * 8) = w; }
}
__device__ __forceinline__ void tconv(LAS unsigned char* lds, const float* __restrict__ src, int K, int Nsrc, bf16_t* __restrict__ dst, int Ndst,
                                      const float* __restrict__ kscale, bool winmap, int& tbase, int bid, int G) {
    const int wid = threadIdx.x >> 6; const int ntile = (K / 64) * (Ndst / 64);
    LAS float* T = (LAS float*)(lds + wid * 16640);
    const int W = G * 8, me = bid * 8 + wid;
    int first = (me - (tbase % W) + W) % W;
    for (int t = first; t < ntile; t += W) tconv_tile(T, src, K, Nsrc, dst, kscale, winmap, t);
    tbase += ntile;
}
__device__ __forceinline__ void phase0(LAS unsigned char* lds, const P& p, int bid, int G) {
    unsigned char* ws = p.ws; const int tid = threadIdx.x, lane = tid & 63, wid = tid >> 6;
    if (bid == 0 && tid == 0) ((unsigned*)ws)[16] = 0u;
    for (int i = bid * NTHR + tid; i < 2 * 9216; i += G * NTHR) ((float*)(ws + WS_SS1))[i] = 0.f;
    for (int row = bid * 8 + wid; row < 10240; row += G * 8) {
        const float* src = row < 8192 ? p.in[0] + (size_t)row * 2048 : (row < 9216 ? p.in[1] + (size_t)(row - 8192) * 2048 : p.in[2] + (size_t)(row - 9216) * 2048);
        const float* g = row < 9216 ? p.in[9] : p.in[22];
        bf16_t* dst = row < 9216 ? (bf16_t*)(ws + WS_XN) + (size_t)row * 2048 : (bf16_t*)(ws + WS_MEMN) + (size_t)(row - 9216) * 2048;
        f32x4 v[8]; float s = 0.f;
#pragma unroll
        for (int i = 0; i < 8; ++i) { v[i] = *(const f32x4*)(src + (i * 64 + lane) * 4); s += v[i][0] * v[i][0] + v[i][1] * v[i][1] + v[i][2] * v[i][2] + v[i][3] * v[i][3]; }
#pragma unroll
        for (int o = 32; o >= 1; o >>= 1) s += __shfl_xor(s, o);
        const float rs = rsqrtf(s * (1.f / 2048.f) + 1e-6f);
#pragma unroll
        for (int i = 0; i < 8; ++i) { const f32x4 gg = *(const f32x4*)(g + (i * 64 + lane) * 4); const f32x4 y = v[i] * rs * gg;
            u32x2 w; w.x = cvt_pk_bf16(y[0], y[1]); w.y = cvt_pk_bf16(y[2], y[3]); *(u32x2*)(dst + (i * 64 + lane) * 4) = w; }
    }
    int tb = 0;
    tconv(lds, p.in[10], 2048, 13328, (bf16_t*)(ws + WS_WIN), 13568, nullptr, true, tb, bid, G);
    tconv(lds, p.in[23], 2048, 2048, (bf16_t*)(ws + WS_WMKV), 2048, nullptr, false, tb, bid, G);
    for (int nb = 0; nb < 8; ++nb) {
        tconv(lds, p.in[13] + (size_t)nb * 16384, 128, 128, (bf16_t*)(ws + WS_WRG) + (size_t)nb * 32768, 128, nullptr, false, tb, bid, G);
        tconv(lds, p.in[15] + (size_t)nb * 16384, 128, 128, (bf16_t*)(ws + WS_WRG) + (size_t)nb * 32768 + 16384, 128, nullptr, false, tb, bid, G);
    }
}

constexpr int GPC = 36864;
__device__ __forceinline__ void gdn_prep_item(LAS unsigned char* lds, const P& p, int item) {
    const int tid = threadIdx.x, lane = tid & 63, wid = __builtin_amdgcn_readfirstlane(tid >> 6), fr = lane & 15, fq = lane >> 4;
    const int c = item & 31, h = (item >> 5) & 7, b = item >> 8;
    const int tok0 = b * 2048 + c * 64;
    const bf16_t* PROJ = (const bf16_t*)(p.ws + WS_PROJ); const float* GBA = (const float*)(p.ws + WS_GBA);
    bf16_t* gp = (bf16_t*)(p.ws + WS_GP) + (size_t)item * GPC;
    LAS bf16_t* qs = (LAS bf16_t*)(lds + 0);
    LAS bf16_t* ks = (LAS bf16_t*)(lds + 17408);
    LAS bf16_t* vs = (LAS bf16_t*)(lds + 34816);
    LAS float* Mf = (LAS float*)(lds + 52224);
    LAS float* sc = (LAS float*)(lds + 114688);
    __syncthreads();
    if (wid == 0) {
        const float gb = GBA[(size_t)(tok0 + lane) * 16 + h], ga = GBA[(size_t)(tok0 + lane) * 16 + 8 + h];
        const float beta = sigm(gb);
        const float g = -__expf(p.in[19][h]) * softplusf(ga + p.in[20][h]);
        float gc = g;
#pragma unroll
        for (int o = 1; o < 64; o <<= 1) { const float t = __shfl_up(gc, o); if (lane >= o) gc += t; }
        const float gl = __shfl(gc, 63);
        sc[lane] = gc; sc[64 + lane] = beta; sc[128 + lane] = __expf(gc); sc[192 + lane] = __expf(gl - gc); sc[256 + lane] = beta * __expf(gc);
        if (lane == 0) ((float*)(p.ws + WS_DEC))[item] = __expf(gl);
    }
    {
        const int r = tid >> 3, seg = tid & 7;
#pragma unroll
        for (int mat = 0; mat < 3; ++mat) {
            const int chm = mat * 1024 + h * 128 + seg * 16;
            float a[16];
#pragma unroll
            for (int i = 0; i < 16; ++i) a[i] = 0.f;
#pragma unroll
            for (int j = 0; j < 4; ++j) { const int t = c * 64 + r - 3 + j;
                if (t >= 0) { const bf16_t* src = PROJ + (size_t)(b * 2048 + t) * NPROJ + C_GQ + chm; const u32x4 x0 = *(const u32x4*)src, x1 = *(const u32x4*)(src + 8);
                    const float* w = p.in[18] + j * 3072 + chm; const f32x4 w0 = *(const f32x4*)w, w1 = *(const f32x4*)(w + 4), w2 = *(const f32x4*)(w + 8), w3 = *(const f32x4*)(w + 12);
                    a[0] += w0[0] * bf_lo(x0.x); a[1] += w0[1] * bf_hi(x0.x); a[2] += w0[2] * bf_lo(x0.y); a[3] += w0[3] * bf_hi(x0.y);
                    a[4] += w1[0] * bf_lo(x0.z); a[5] += w1[1] * bf_hi(x0.z); a[6] += w1[2] * bf_lo(x0.w); a[7] += w1[3] * bf_hi(x0.w);
                    a[8] += w2[0] * bf_lo(x1.x); a[9] += w2[1] * bf_hi(x1.x); a[10] += w2[2] * bf_lo(x1.y); a[11] += w2[3] * bf_hi(x1.y);
                    a[12] += w3[0] * bf_lo(x1.z); a[13] += w3[1] * bf_hi(x1.z); a[14] += w3[2] * bf_lo(x1.w); a[15] += w3[3] * bf_hi(x1.w); } }
            float ss = 0.f;
#pragma unroll
            for (int i = 0; i < 16; ++i) { a[i] = siluf(a[i]); ss += a[i] * a[i]; }
            if (mat < 2) { ss += __shfl_xor(ss, 1); ss += __shfl_xor(ss, 2); ss += __shfl_xor(ss, 4);
                float rn = rsqrtf(ss + 1e-6f); if (mat == 0) rn *= 0.08838834764831845f;
#pragma unroll
                for (int i = 0; i < 16; ++i) a[i] *= rn; }
            LAS bf16_t* dst = (mat == 0 ? qs : (mat == 1 ? ks : vs)) + r * 136 + seg * 16;
            u32x4 w0, w1; w0.x = cvt_pk_bf16(a[0], a[1]); w0.y = cvt_pk_bf16(a[2], a[3]); w0.z = cvt_pk_bf16(a[4], a[5]); w0.w = cvt_pk_bf16(a[6], a[7]);
            w1.x = cvt_pk_bf16(a[8], a[9]); w1.y = cvt_pk_bf16(a[10], a[11]); w1.z = cvt_pk_bf16(a[12], a[13]); w1.w = cvt_pk_bf16(a[14], a[15]);
            *(LAS u32x4*)dst = w0; *(LAS u32x4*)(dst + 8) = w1;
        }
    }
    LDS_BAR();
    {
        const int r = tid & 63, seg = tid >> 6; const float ed = sc[192 + r];
        bf16_t* kdt = gp + 24576;
#pragma unroll
        for (int i = 0; i < 16; ++i) { const int ch = seg * 16 + i; const float kv = bf2f(ks[r * 136 + ch]);
            kdt[ch * 64 + r] = f2bf(kv * ed); }
    }
    {
        const int r = tid >> 3, seg = tid & 7; const float eg = sc[128 + r];
        const u32x4 x0 = *(const LAS u32x4*)(qs + r * 136 + seg * 16), x1 = *(const LAS u32x4*)(qs + r * 136 + seg * 16 + 8);
        u32x4 w0, w1;
        w0.x = cvt_pk_bf16(bf_lo(x0.x) * eg, bf_hi(x0.x) * eg); w0.y = cvt_pk_bf16(bf_lo(x0.y) * eg, bf_hi(x0.y) * eg); w0.z = cvt_pk_bf16(bf_lo(x0.z) * eg, bf_hi(x0.z) * eg); w0.w = cvt_pk_bf16(bf_lo(x0.w) * eg, bf_hi(x0.w) * eg);
        w1.x = cvt_pk_bf16(bf_lo(x1.x) * eg, bf_hi(x1.x) * eg); w1.y = cvt_pk_bf16(bf_lo(x1.y) * eg, bf_hi(x1.y) * eg); w1.z = cvt_pk_bf16(bf_lo(x1.z) * eg, bf_hi(x1.z) * eg); w1.w = cvt_pk_bf16(bf_lo(x1.w) * eg, bf_hi(x1.w) * eg);
        bf16_t* d = gp + 8192 + r * 128 + seg * 16; *(u32x4*)d = w0; *(u32x4*)(d + 8) = w1;
    }
    {
        bf16_t* at = gp + 32768;
#pragma unroll
        for (int i4 = 0; i4 < 4; ++i4) { const int T = wid * 4 + i4, which = T >> 4, it = (T >> 2) & 3, jt = T & 3;
            if (jt <= it) {
                f32x4 acc = (f32x4){0.f, 0.f, 0.f, 0.f}; const LAS bf16_t* A = which ? qs : ks;
                bf16x8 fa[4], fb[4];
#pragma unroll
                for (int k = 0; k < 4; ++k) { fa[k] = *(const LAS bf16x8*)(A + (16 * it + fr) * 136 + 32 * k + fq * 8); fb[k] = *(const LAS bf16x8*)(ks + (16 * jt + fr) * 136 + 32 * k + fq * 8); }
#pragma unroll
                for (int k = 0; k < 4; ++k) acc = MFMA16(fa[k], fb[k], acc);
#pragma unroll
                for (int r = 0; r < 4; ++r) { const int i = 16 * it + fq * 4 + r, j = 16 * jt + fr; const float d = (j <= i) ? __expf(sc[i] - sc[j]) : 0.f;
                    if (!which) { if (j < i) Mf[i * 64 + j] = sc[64 + i] * acc[r] * d; }
                    else at[i * 64 + j] = f2bf(acc[r] * d); }
            } else if (which) {
#pragma unroll
                for (int r = 0; r < 4; ++r) at[(16 * it + fq * 4 + r) * 64 + 16 * jt + fr] = (bf16_t)0;
            }
        }
    }
    LDS_BAR();
    if (wid < 4) {
        const bool isk = wid >= 2; const int col = (wid & 1) * 64 + lane;
        float X[64]; int zoff; asm volatile("v_mov_b32 %0, 0" : "=v"(zoff)); const LAS float* Mz = Mf + zoff; const LAS float* scz = sc + zoff + (isk ? 256 : 64);
        const LAS bf16_t* src = (const LAS bf16_t*)(lds + (isk ? 17408 : 34816)) + col + zoff;
#pragma unroll
        for (int i = 0; i < 64; ++i) {
            f32x4 mrow[(i + 3) / 4 > 0 ? (i + 3) / 4 : 1];
#pragma unroll
            for (int v = 0; v < (i + 3) / 4; ++v) mrow[v] = *(const LAS f32x4*)(Mz + i * 64 + 4 * v);
            float a0 = bf2f(src[i * 136]) * scz[i], a1 = 0.f, a2 = 0.f, a3 = 0.f;
#pragma unroll
            for (int j = 0; j < i; ++j) { const float mv = mrow[j >> 2][j & 3];
                if ((j & 3) == 0) a0 -= mv * X[j]; else if ((j & 3) == 1) a1 -= mv * X[j]; else if ((j & 3) == 2) a2 -= mv * X[j]; else a3 -= mv * X[j]; }
            X[i] = (a0 + a1) + (a2 + a3);
            asm volatile("" ::: "memory");
        }
        if (!isk) {
            bf16_t* d = gp + 16384 + col * 64;
#pragma unroll
            for (int e = 0; e < 8; ++e) { u32x4 w; w.x = cvt_pk_bf16(X[8 * e], X[8 * e + 1]); w.y = cvt_pk_bf16(X[8 * e + 2], X[8 * e + 3]); w.z = cvt_pk_bf16(X[8 * e + 4], X[8 * e + 5]); w.w = cvt_pk_bf16(X[8 * e + 6], X[8 * e + 7]);
                *(u32x4*)(d + 8 * e) = w; }
        } else {
#pragma unroll
            for (int i = 0; i < 64; ++i) gp[i * 128 + col] = f2bf(X[i]);
        }
    }
}

__device__ __forceinline__ void gdn_seq_item(LAS unsigned char* lds, const P& p, int item) {
    const int tid = threadIdx.x, lane = tid & 63, wid = __builtin_amdgcn_readfirstlane(tid >> 6), fr = lane & 15, fq = lane >> 4;
    const int b = item >> 3, h = item & 7;
    const bf16_t* gp = (const bf16_t*)(p.ws + WS_GP) + (size_t)item * 32 * GPC;
    const float* DEC = (const float*)(p.ws + WS_DEC) + item * 32;
    const bf16_t* PROJ = (const bf16_t*)(p.ws + WS_PROJ);
    bf16_t* YG = (bf16_t*)(p.ws + WS_YCAT) + (size_t)9216 * 1024;
    LAS bf16_t* KCD = (LAS bf16_t*)(lds + 0);
    LAS bf16_t* QG = (LAS bf16_t*)(lds + 17408);
    LAS bf16_t* VT = (LAS bf16_t*)(lds + 34816);
    LAS bf16_t* KDT = (LAS bf16_t*)(lds + 53248);
    LAS bf16_t* AT = (LAS bf16_t*)(lds + 71680);
    LAS bf16_t* ST = (LAS bf16_t*)(lds + 80896);
    LAS bf16_t* VNT = (LAS bf16_t*)(lds + 115712);
    LAS float* SSQ = (LAS float*)(lds + 134144);
#if DBG_SEQ_SUM
    { float* so = p.out + O_GSP + (size_t)item * 16384;
      for (int e = tid; e < 16384; e += NTHR) { const int dk = e >> 7, dv = e & 127; float a = 0.f;
          for (int c = 0; c < 32; ++c) { const bf16_t* g = gp + (size_t)c * GPC; a += bf2f(g[(dk & 63) * 128 + dv]) + bf2f(g[16384 + dv * 64 + (dk & 63)]) + bf2f(g[8192 + (dk & 63) * 128 + dv]) + bf2f(g[24576 + dv * 64 + (dk & 63)]) + bf2f(g[32768 + (dk & 63) * 64 + (dv & 63)]) + DEC[c]; }
          so[e] = a; }
      for (int e = tid; e < 2048 * 128; e += NTHR) YG[((size_t)b * 2048 + (e >> 7)) * 1024 + h * 128 + (e & 127)] = 0;
      return; }
#endif
    u32x4 pf[9];
#define GS_LOAD(cc) do { _Pragma("unroll") for (int i = 0; i < 9; ++i) pf[i] = *(const u32x4*)(gp + (size_t)(cc) * GPC + (size_t)(tid + NTHR * i) * 8); } while (0)
#define GS_STORE() do { _Pragma("unroll") for (int i = 0; i < 9; ++i) { const int q = tid + NTHR * i; int off; \
        if (i < 2) off = 0 + (q >> 4) * 272 + (q & 15) * 16; else if (i < 4) off = 17408 + ((q - 1024) >> 4) * 272 + (q & 15) * 16; \
        else if (i < 6) off = 34816 + ((q - 2048) >> 3) * 144 + (q & 7) * 16; else if (i < 8) off = 53248 + ((q - 3072) >> 3) * 144 + (q & 7) * 16; \
        else off = 71680 + ((q - 4096) >> 3) * 144 + (q & 7) * 16; \
        *(LAS u32x4*)(lds + off) = pf[i]; } } while (0)
    __syncthreads();
    GS_LOAD(0);
    for (int i = tid; i < 34816 / 16; i += NTHR) *(LAS u32x4*)(lds + 80896 + i * 16) = (u32x4){0u, 0u, 0u, 0u};
    GS_STORE();
    f32x4 Sacc[8];
#pragma unroll
    for (int i = 0; i < 8; ++i) Sacc[i] = (f32x4){0.f, 0.f, 0.f, 0.f};
    __syncthreads();
    const int it = wid & 3, dvb = (wid >> 2) * 4;
    for (int c = 0; c < 32; ++c) {
        if (c + 1 < 32) GS_LOAD(c + 1);
        const float dec = DEC[c];
        u32x2 zpf[4];
        { const size_t gt = (size_t)b * 2048 + c * 64 + 16 * it + fr;
#pragma unroll
          for (int q = 0; q < 4; ++q) zpf[q] = *(const u32x2*)(PROJ + gt * NPROJ + C_GZ + h * 128 + 16 * (dvb + q) + fq * 4); }
        {
            bf16x8 a[4];
#pragma unroll
            for (int k = 0; k < 4; ++k) a[k] = *(const LAS bf16x8*)(KCD + (16 * it + fr) * 136 + 32 * k + fq * 8);
            bf16x8 sb[4][4]; u32x2 vvq[4];
#pragma unroll
            for (int q = 0; q < 4; ++q) {
#pragma unroll
                for (int k = 0; k < 4; ++k) sb[q][k] = *(const LAS bf16x8*)(ST + (16 * (dvb + q) + fr) * 136 + 32 * k + fq * 8);
                vvq[q] = *(const LAS u32x2*)(VT + (16 * (dvb + q) + fr) * 72 + 16 * it + fq * 4); }
#pragma unroll
            for (int q = 0; q < 4; ++q) { const int dvt = dvb + q; f32x4 acc = (f32x4){0.f, 0.f, 0.f, 0.f};
#pragma unroll
                for (int k = 0; k < 4; ++k) acc = MFMA16(a[k], sb[q][k], acc);
                const u32x2 vv = vvq[q];
                u32x2 w; w.x = cvt_pk_bf16(bf_lo(vv.x) - acc[0], bf_hi(vv.x) - acc[1]); w.y = cvt_pk_bf16(bf_lo(vv.y) - acc[2], bf_hi(vv.y) - acc[3]);
                *(LAS u32x2*)(VNT + (16 * dvt + fr) * 72 + 16 * it + fq * 4) = w; }
        }
        LDS_BAR();
        f32x4 oacc[4];
        {
            bf16x8 bq[4], ba[2];
#pragma unroll
            for (int k = 0; k < 4; ++k) bq[k] = *(const LAS bf16x8*)(QG + (16 * it + fr) * 136 + 32 * k + fq * 8);
#pragma unroll
            for (int k = 0; k < 2; ++k) ba[k] = *(const LAS bf16x8*)(AT + (16 * it + fr) * 72 + 32 * k + fq * 8);
            float s = 0.f;
#pragma unroll
            for (int q2 = 0; q2 < 4; q2 += 2) {
              bf16x8 sa[2][4], va[2][2];
#pragma unroll
              for (int e = 0; e < 2; ++e) {
#pragma unroll
                for (int k = 0; k < 4; ++k) sa[e][k] = *(const LAS bf16x8*)(ST + (16 * (dvb + q2 + e) + fr) * 136 + 32 * k + fq * 8);
#pragma unroll
                for (int k = 0; k < 2; ++k) va[e][k] = *(const LAS bf16x8*)(VNT + (16 * (dvb + q2 + e) + fr) * 72 + 32 * k + fq * 8); }
#pragma unroll
              for (int e = 0; e < 2; ++e) { const int q = q2 + e; f32x4 acc = (f32x4){0.f, 0.f, 0.f, 0.f};
#pragma unroll
                for (int k = 0; k < 4; ++k) acc = MFMA16(sa[e][k], bq[k], acc);
#pragma unroll
                for (int k = 0; k < 2; ++k) acc = MFMA16(va[e][k], ba[k], acc);
                oacc[q] = acc; s += acc[0] * acc[0] + acc[1] * acc[1] + acc[2] * acc[2] + acc[3] * acc[3]; }
            }
            s += __shfl_xor(s, 16); s += __shfl_xor(s, 32);
            if (fq == 0) SSQ[(wid >> 2) * 64 + 16 * it + fr] = s;
        }
        {
            bf16x8 a[2];
#pragma unroll
            for (int k = 0; k < 2; ++k) a[k] = *(const LAS bf16x8*)(KDT + (16 * wid + fr) * 72 + 32 * k + fq * 8);
            bf16x8 vb[8][2];
#pragma unroll
            for (int dvt = 0; dvt < 8; ++dvt)
#pragma unroll
                for (int k = 0; k < 2; ++k) vb[dvt][k] = *(const LAS bf16x8*)(VNT + (16 * dvt + fr) * 72 + 32 * k + fq * 8);
#pragma unroll
            for (int dvt = 0; dvt < 8; ++dvt) { f32x4 acc = Sacc[dvt] * dec;
#pragma unroll
                for (int k = 0; k < 2; ++k) acc = MFMA16(a[k], vb[dvt][k], acc);
                Sacc[dvt] = acc; }
        }
        LDS_BAR();
        {
#pragma unroll
            for (int dvt = 0; dvt < 8; ++dvt) { u32x2 w; w.x = cvt_pk_bf16(Sacc[dvt][0], Sacc[dvt][1]); w.y = cvt_pk_bf16(Sacc[dvt][2], Sacc[dvt][3]);
                *(LAS u32x2*)(ST + (16 * dvt + fr) * 136 + 16 * wid + fq * 4) = w; }
            const float tot = SSQ[16 * it + fr] + SSQ[64 + 16 * it + fr]; const float rs = rsqrtf(tot * (1.f / 128.f) + 1e-6f);
            const size_t gtok = (size_t)b * 2048 + c * 64 + 16 * it + fr;
#pragma unroll
            for (int q = 0; q < 4; ++q) { const int dv = 16 * (dvb + q) + fq * 4;
                const u32x2 z = zpf[q]; const f32x4 gn = *(const f32x4*)(p.in[21] + dv);
                u32x2 w; w.x = cvt_pk_bf16(DBGFIN(oacc[q][0] * rs * gn[0] * bf_lo(z.x)), DBGFIN(oacc[q][1] * rs * gn[1] * bf_hi(z.x)));
                w.y = cvt_pk_bf16(DBGFIN(oacc[q][2] * rs * gn[2] * bf_lo(z.y)), DBGFIN(oacc[q][3] * rs * gn[3] * bf_hi(z.y)));
                *(u32x2*)(YG + gtok * 1024 + h * 128 + dv) = w; }
            if (c + 1 < 32) GS_STORE();
        }
        LDS_BAR();
    }
    {
        float* so = p.out + O_GSP + (size_t)item * 16384;
#pragma unroll
        for (int dvt = 0; dvt < 8; ++dvt)
#pragma unroll
            for (int r = 0; r < 4; ++r) so[(16 * wid + fq * 4 + r) * 128 + 16 * dvt + fr] = Sacc[dvt][r];
    }
#undef GS_LOAD
#undef GS_STORE
}

template <bool PROMPT>
__device__ __forceinline__ void rglru_item(LAS unsigned char* lds, const P& p, int item) {
    const int tid = threadIdx.x, lane = tid & 63, wid = __builtin_amdgcn_readfirstlane(tid >> 6), fr = lane & 15, fq = lane >> 4;
    const int q = item & 3, n = (item >> 2) & 7, bb0 = item >> 5;
    const int gq0 = n * 128 + 32 * q;
    const bf16_t* PROJ = (const bf16_t*)(p.ws + WS_PROJ);
    bf16_t* YR = (bf16_t*)(p.ws + WS_YCAT);
    LAS bf16_t* WL = (LAS bf16_t*)(lds + 0);
    LAS bf16_t* XA = (LAS bf16_t*)(lds + 17408);
    LAS bf16_t* RG = (LAS bf16_t*)(lds + 52224);
    LAS float* WT = (LAS float*)(lds + 62464);
    LAS float* HC = (LAS float*)(lds + 64512);
    LAS float* PAR = (LAS float*)(lds + 64768);
    __syncthreads();
    {   const bf16_t* wsrc = (const bf16_t*)(p.ws + WS_WRG) + (size_t)n * 32768;
#pragma unroll
        for (int i = 0; i < 2; ++i) { const int c = tid + NTHR * i, r = c >> 4, c8 = c & 15; const int srow = (r < 32) ? (32 * q + r) : (128 + 32 * q + (r - 32));
            *(LAS u32x4*)(WL + r * 136 + c8 * 8) = *(const u32x4*)(wsrc + (size_t)srow * 128 + c8 * 8); }
        if (tid < 64) HC[tid] = 0.f;
        if (tid < 32) { PAR[tid] = p.in[14][gq0 + tid]; PAR[32 + tid] = p.in[16][gq0 + tid]; PAR[64 + tid] = -8.f * softplusf(-p.in[17][gq0 + tid]); } }
    const int ntile = PROMPT ? 16 : 1;
    const int crow = tid >> 2, cpart = tid & 3;
    const int cg = tid & 15, r0 = (tid >> 4) * 4;
    const int gc8 = n * 128 + 8 * cg;
    f32x4 wlo[4], whi[4], blo, bhi;
#pragma unroll
    for (int j = 0; j < 4; ++j) { wlo[j] = *(const f32x4*)(p.in[11] + j * 1024 + gc8); whi[j] = *(const f32x4*)(p.in[11] + j * 1024 + gc8 + 4); }
    blo = *(const f32x4*)(p.in[12] + gc8); bhi = *(const f32x4*)(p.in[12] + gc8 + 4);
    u32x4 xr[7], rgv;
#define RG_LOAD(TT) do { const size_t gr_ = PROMPT ? (size_t)bb0 * 2048 + (TT) * 128 + crow : (size_t)8192 + bb0 * 128 + crow; \
        rgv = *(const u32x4*)(PROJ + gr_ * NPROJ + C_RG + gq0 + 8 * cpart); \
        _Pragma("unroll") for (int k = 0; k < 7; ++k) { const int t_ = PROMPT ? (TT) * 128 + r0 - 3 + k : (r0 & 7) - 3 + k; const int tc_ = t_ > 0 ? t_ : 0; \
            const size_t sr_ = PROMPT ? (size_t)bb0 * 2048 + tc_ : (size_t)8192 + (bb0 * 16 + (r0 >> 3)) * 8 + tc_; \
            xr[k] = *(const u32x4*)(PROJ + sr_ * NPROJ + C_RX + gc8); } } while (0)
    RG_LOAD(0);
    for (int tt = 0; tt < ntile; ++tt) {
        const size_t grow_c = PROMPT ? (size_t)bb0 * 2048 + tt * 128 + crow : (size_t)8192 + bb0 * 128 + crow;
        {
#pragma unroll
            for (int rr = 0; rr < 4; ++rr) { f32x4 alo = blo, ahi = bhi;
#pragma unroll
                for (int j = 0; j < 4; ++j) { const int t = PROMPT ? tt * 128 + r0 + rr - 3 + j : (r0 & 7) + rr - 3 + j;
                    if (t >= 0) { const u32x4 x = xr[rr + j];
                        alo[0] += wlo[j][0] * bf_lo(x.x); alo[1] += wlo[j][1] * bf_hi(x.x); alo[2] += wlo[j][2] * bf_lo(x.y); alo[3] += wlo[j][3] * bf_hi(x.y);
                        ahi[0] += whi[j][0] * bf_lo(x.z); ahi[1] += whi[j][1] * bf_hi(x.z); ahi[2] += whi[j][2] * bf_lo(x.w); ahi[3] += whi[j][3] * bf_hi(x.w);
                    } else if (!PROMPT) { const float* srcf = p.in[5] + (size_t)((bb0 * 16 + (r0 >> 3)) * 3 + 3 + t) * 1024 + gc8;
                        const f32x4 x0 = *(const f32x4*)srcf, x1 = *(const f32x4*)(srcf + 4); alo += wlo[j] * x0; ahi += whi[j] * x1; }
                }
                u32x4 w; w.x = cvt_pk_bf16(alo[0], alo[1]); w.y = cvt_pk_bf16(alo[2], alo[3]); w.z = cvt_pk_bf16(ahi[0], ahi[1]); w.w = cvt_pk_bf16(ahi[2], ahi[3]);
                *(LAS u32x4*)(XA + (r0 + rr) * 136 + 8 * cg) = w; }
            *(LAS u32x4*)(RG + crow * 40 + 8 * cpart) = rgv;
            if (tt + 1 < ntile) RG_LOAD(tt + 1);
        }
        LDS_BAR();
        f32x4 acc[4];
        {   bf16x8 a[4];
#pragma unroll
            for (int k = 0; k < 4; ++k) a[k] = *(const LAS bf16x8*)(XA + (16 * wid + fr) * 136 + 32 * k + fq * 8);
            bf16x8 wf[4][4];
#pragma unroll
            for (int nt = 0; nt < 4; ++nt)
#pragma unroll
                for (int k = 0; k < 4; ++k) wf[nt][k] = *(const LAS bf16x8*)(WL + (16 * nt + fr) * 136 + 32 * k + fq * 8);
#pragma unroll
            for (int nt = 0; nt < 4; ++nt) { f32x4 c = (f32x4){0.f, 0.f, 0.f, 0.f};
#pragma unroll
                for (int k = 0; k < 4; ++k) c = MFMA16(a[k], wf[nt][k], c);
                acc[nt] = c; } }
        float eA[2], eU[2]; float xcv[2][4], pbx[2], pba[2], pc8[2];
#pragma unroll
        for (int nt = 0; nt < 2; ++nt) { const int ch = 16 * nt + fr; pbx[nt] = PAR[ch]; pba[nt] = PAR[32 + ch]; pc8[nt] = PAR[64 + ch];
#pragma unroll
            for (int r = 0; r < 4; ++r) xcv[nt][r] = bf2f(XA[(16 * wid + 4 * fq + r) * 136 + 32 * q + ch]); }
#pragma unroll
        for (int nt = 0; nt < 2; ++nt) { const int ch = 16 * nt + fr;
            const float bx = pbx[nt], ba = pba[nt], c8 = pc8[nt];
#pragma unroll
            for (int r = 0; r < 4; ++r) { const float gi = sigm(acc[nt][r] + bx), gr = sigm(acc[nt + 2][r] + ba); const float la = c8 * gr;
                const float av = __expf(la), mult = sqrtf(fmaxf(1.f - av * av, 0.f)); const float xc = xcv[nt][r];
                acc[nt][r] = mult * gi * xc; acc[nt + 2][r] = av; }
            float A = acc[nt + 2][0], U = acc[nt][0];
#pragma unroll
            for (int r = 1; r < 4; ++r) { U = acc[nt + 2][r] * U + acc[nt][r]; A *= acc[nt + 2][r]; }
            if (PROMPT) {
                float A1 = __shfl_up(A, 16), U1 = __shfl_up(U, 16); if (fq >= 1) { U = A * U1 + U; A = A * A1; }
                A1 = __shfl_up(A, 32); U1 = __shfl_up(U, 32); if (fq >= 2) { U = A * U1 + U; A = A * A1; }
                float Ae = __shfl_up(A, 16), Ue = __shfl_up(U, 16); if (fq == 0) { Ae = 1.f; Ue = 0.f; }
                eA[nt] = Ae; eU[nt] = Ue;
                if (fq == 3) { WT[(wid * 32 + ch) * 2] = A; WT[(wid * 32 + ch) * 2 + 1] = U; }
            } else {
                float Ae = __shfl_up(A, 16), Ue = __shfl_up(U, 16); if ((fq & 1) == 0) { Ae = 1.f; Ue = 0.f; }
                eA[nt] = Ae; eU[nt] = Ue;
            }
        }
        LDS_BAR();
#pragma unroll
        for (int nt = 0; nt < 2; ++nt) { const int ch = 16 * nt + fr, gch = gq0 + ch;
            float hv;
            if (PROMPT) { hv = HC[(tt & 1) * 32 + ch]; float wa_[7], wu_[7];
#pragma unroll
                for (int w2 = 0; w2 < 7; ++w2) { wa_[w2] = WT[(w2 * 32 + ch) * 2]; wu_[w2] = WT[(w2 * 32 + ch) * 2 + 1]; }
#pragma unroll
                for (int w2 = 0; w2 < 7; ++w2) if (w2 < wid) hv = wa_[w2] * hv + wu_[w2];
            } else hv = p.in[6][(size_t)(bb0 * 16 + wid * 2 + (fq >> 1)) * 1024 + gch];
            hv = eA[nt] * hv + eU[nt];
#pragma unroll
            for (int r = 0; r < 4; ++r) { hv = acc[nt + 2][r] * hv + acc[nt][r];
                LAS bf16_t* e = RG + (16 * wid + 4 * fq + r) * 40 + ch; *e = f2bf(hv * bf2f(*e)); }
            if (PROMPT) { if (wid == 7 && fq == 3) { HC[((tt & 1) ^ 1) * 32 + ch] = hv; if (tt == 15) p.out[O_RHP + (size_t)bb0 * 1024 + gch] = hv; } }
            else { if (fq & 1) p.out[O_RHS + (size_t)(bb0 * 16 + wid * 2 + (fq >> 1)) * 1024 + gch] = hv; }
        }
        LDS_BAR();
        *(u32x4*)(YR + grow_c * 1024 + gq0 + 8 * cpart) = *(const LAS u32x4*)(RG + crow * 40 + 8 * cpart);
    }
#undef RG_LOAD
}

__device__ __forceinline__ void gdn_sample_pass(LAS unsigned char* lds, const P& p, int pass) {
    const int tid = threadIdx.x, lane = tid & 63, sub = tid >> 8, idx = tid & 255, v = idx >> 1, kh = idx & 1, wv = (tid >> 6) & 3;
    const int item = pass * 2 + sub, b = item >> 3, h = item & 7;
    const bf16_t* PROJ = (const bf16_t*)(p.ws + WS_PROJ); const float* GBA = (const float*)(p.ws + WS_GBA);
    bf16_t* YG = (bf16_t*)(p.ws + WS_YCAT) + (size_t)9216 * 1024;
    LAS float* qv = (LAS float*)(lds + sub * 16896);
    LAS float* kv = qv + 1024;
    LAS float* vv = kv + 1024;
    LAS float* ov = vv + 1024;
    LAS float* red = ov + 1024;
    LAS float* db = red + 96;
    __syncthreads();
    {
        float yq[8], yk[8];
#pragma unroll
        for (int mat = 0; mat < 3; ++mat) { const int ch = mat * 1024 + h * 128 + v; float x[11];
#pragma unroll
            for (int j = 0; j < 3; ++j) x[j] = p.in[7][(size_t)(b * 3 + j) * 3072 + ch];
#pragma unroll
            for (int t = 0; t < 8; ++t) x[3 + t] = bf2f(PROJ[(size_t)(8192 + b * 8 + t) * NPROJ + C_GQ + ch]);
            const float w0 = p.in[18][ch], w1 = p.in[18][3072 + ch], w2 = p.in[18][6144 + ch], w3 = p.in[18][9216 + ch];
#pragma unroll
            for (int t = 0; t < 8; ++t) { const float y = siluf(w0 * x[t] + w1 * x[t + 1] + w2 * x[t + 2] + w3 * x[t + 3]); if (mat == 0) yq[t] = y; else if (mat == 1) yk[t] = y; else if (kh == 0) vv[t * 128 + v] = y; } }
#pragma unroll
        for (int t = 0; t < 8; ++t) { float sq = kh ? 0.f : yq[t] * yq[t], sk = kh ? 0.f : yk[t] * yk[t];
#pragma unroll
            for (int o = 32; o >= 1; o >>= 1) { sq += __shfl_xor(sq, o); sk += __shfl_xor(sk, o); }
            if (lane == 0) { red[wv * 8 + t] = sq; red[32 + wv * 8 + t] = sk; } }
        if (idx < 8) { const float* gr = GBA + (size_t)(8192 + b * 8 + idx) * 16; db[8 + idx] = sigm(gr[h]); db[idx] = __expf(-__expf(p.in[19][h]) * softplusf(gr[8 + h] + p.in[20][h])); }
        __syncthreads();
        if (kh == 0) {
#pragma unroll
            for (int t = 0; t < 8; ++t) { const float rq = rsqrtf(red[t] + red[8 + t] + red[16 + t] + red[24 + t] + 1e-6f) * 0.08838834764831845f, rk = rsqrtf(red[32 + t] + red[40 + t] + red[48 + t] + red[56 + t] + 1e-6f);
                qv[t * 128 + v] = yq[t] * rq; kv[t * 128 + v] = yk[t] * rk; } }
    }
    float Sc[64];
    { const float* s0 = p.in[8] + (size_t)item * 16384 + (size_t)kh * 64 * 128 + v;
#pragma unroll
        for (int k = 0; k < 64; ++k) Sc[k] = s0[k * 128]; }
    __syncthreads();
#pragma unroll 1
    for (int t = 0; t < 8; ++t) {
        const float dect = db[t], betat = db[8 + t], vt = vv[t * 128 + v];
        const LAS float* kt = kv + t * 128 + kh * 64; const LAS float* qt = qv + t * 128 + kh * 64;
        f32x4 kreg[16];
#pragma unroll
        for (int k = 0; k < 16; ++k) kreg[k] = *(const LAS f32x4*)(kt + 4 * k);
        float d0 = 0.f, d1 = 0.f, d2 = 0.f, d3 = 0.f;
#pragma unroll
        for (int k = 0; k < 64; k += 4) { const f32x4 kk = kreg[k >> 2]; d0 += Sc[k] * kk[0]; d1 += Sc[k + 1] * kk[1]; d2 += Sc[k + 2] * kk[2]; d3 += Sc[k + 3] * kk[3]; }
        float dot = (d0 + d1) + (d2 + d3); dot += __shfl_xor(dot, 1);
        const float rr = betat * (vt - dect * dot);
        float o0 = 0.f, o1 = 0.f, o2 = 0.f, o3 = 0.f;
#pragma unroll
        for (int hh = 0; hh < 2; ++hh) { f32x4 qreg[8];
#pragma unroll
            for (int k = 0; k < 8; ++k) qreg[k] = *(const LAS f32x4*)(qt + 32 * hh + 4 * k);
#pragma unroll
            for (int k8 = 0; k8 < 8; ++k8) { const int k = 32 * hh + 4 * k8; const f32x4 kk = kreg[k >> 2], qq = qreg[k8];
                Sc[k] = dect * Sc[k] + kk[0] * rr; Sc[k + 1] = dect * Sc[k + 1] + kk[1] * rr; Sc[k + 2] = dect * Sc[k + 2] + kk[2] * rr; Sc[k + 3] = dect * Sc[k + 3] + kk[3] * rr;
                o0 += Sc[k] * qq[0]; o1 += Sc[k + 1] * qq[1]; o2 += Sc[k + 2] * qq[2]; o3 += Sc[k + 3] * qq[3]; } }
        float ot = (o0 + o1) + (o2 + o3); ot += __shfl_xor(ot, 1);
        if (kh == 0) ov[t * 128 + v] = ot;
    }
    { float* so = p.out + O_GSS + (size_t)item * 16384 + (size_t)kh * 64 * 128 + v;
#pragma unroll
        for (int k = 0; k < 64; ++k) so[k * 128] = Sc[k]; }
    __syncthreads();
#pragma unroll
    for (int t = 0; t < 8; ++t) { const float ot = ov[t * 128 + v]; float s = kh ? 0.f : ot * ot;
#pragma unroll
        for (int oo = 32; oo >= 1; oo >>= 1) s += __shfl_xor(s, oo);
        if (lane == 0) red[64 + wv * 8 + t] = s; }
    __syncthreads();
    if (kh == 0) {
        const float gn = p.in[21][v];
#pragma unroll
        for (int t = 0; t < 8; ++t) { const float rs = rsqrtf((red[64 + t] + red[72 + t] + red[80 + t] + red[88 + t]) * (1.f / 128.f) + 1e-6f); const size_t grow = (size_t)8192 + b * 8 + t;
            const float z = bf2f(PROJ[grow * NPROJ + C_GZ + h * 128 + v]);
            YG[grow * 1024 + h * 128 + v] = f2bf(ov[t * 128 + v] * rs * gn * z); } }
}

template <bool F32SRC>
__device__ __forceinline__ void attn_stage(LAS unsigned char* lds, const void* src, int half) {
    const int tid = threadIdx.x;
    if (F32SRC) { const float* s = (const float*)src + (size_t)half * 128 * 1024; f32x4 a[8], b[8];
#pragma unroll
        for (int i = 0; i < 8; ++i) { const int q = tid + NTHR * i; const float* g = s + (size_t)(q >> 5) * 1024 + (q & 31) * 8; a[i] = *(const f32x4*)g; b[i] = *(const f32x4*)(g + 4); }
#pragma unroll
        for (int i = 0; i < 8; ++i) { const int q = tid + NTHR * i; u32x4 w; w.x = cvt_pk_bf16(a[i][0], a[i][1]); w.y = cvt_pk_bf16(a[i][2], a[i][3]); w.z = cvt_pk_bf16(b[i][0], b[i][1]); w.w = cvt_pk_bf16(b[i][2], b[i][3]);
            *(LAS u32x4*)(lds + (q >> 5) * 528 + (q & 31) * 16) = w; }
    } else { const bf16_t* s = (const bf16_t*)src + (size_t)half * 128 * 1024; u32x4 a[8];
#pragma unroll
        for (int i = 0; i < 8; ++i) { const int q = tid + NTHR * i; a[i] = *(const u32x4*)(s + (size_t)(q >> 5) * 1024 + (q & 31) * 8); }
#pragma unroll
        for (int i = 0; i < 8; ++i) { const int q = tid + NTHR * i; *(LAS u32x4*)(lds + (q >> 5) * 528 + (q & 31) * 16) = a[i]; }
    }
}
template <bool F32SRC>
__device__ __forceinline__ void attn_item(LAS unsigned char* lds, const bf16_t* Q, int nrows, const void* Kb, const void* Vb, bf16_t* O) {
    const int tid = threadIdx.x, lane = tid & 63, wid = __builtin_amdgcn_readfirstlane(tid >> 6), fr = lane & 15, fq = lane >> 4;
    const bool active = (16 * wid < nrows);
    LAS unsigned char* PSw = lds + 69632 + wid * 8448;
    __syncthreads();
    bf16x8 qf[8];
    { const int row = min(16 * wid + fr, nrows - 1);
#pragma unroll
        for (int k = 0; k < 8; ++k) qf[k] = *(const bf16x8*)(Q + (size_t)row * NPROJ + 32 * k + fq * 8); }
    f32x4 sacc[16];
#pragma unroll
    for (int i = 0; i < 16; ++i) sacc[i] = (f32x4){0.f, 0.f, 0.f, 0.f};
#pragma unroll
    for (int half = 0; half < 2; ++half) {
        attn_stage<F32SRC>(lds, Kb, half);
        __syncthreads();
        if (active) {
#pragma unroll
            for (int mt = 0; mt < 8; mt += 2) { bf16x8 kf[2][8];
#pragma unroll
                for (int e = 0; e < 2; ++e)
#pragma unroll
                    for (int k = 0; k < 8; ++k) kf[e][k] = *(const LAS bf16x8*)(lds + (16 * (mt + e) + fr) * 528 + (32 * k + fq * 8) * 2);
#pragma unroll
                for (int e = 0; e < 2; ++e)
#pragma unroll
                    for (int k = 0; k < 8; ++k) sacc[half * 8 + mt + e] = MFMA16(kf[e][k], qf[k], sacc[half * 8 + mt + e]); }
        }
        __syncthreads();
    }
    if (active) {
        float mx = -3.0e38f;
#pragma unroll
        for (int mt = 0; mt < 16; ++mt)
#pragma unroll
            for (int r = 0; r < 4; ++r) mx = fmaxf(mx, sacc[mt][r]);
        mx = fmaxf(mx, __shfl_xor(mx, 16)); mx = fmaxf(mx, __shfl_xor(mx, 32));
        float sum = 0.f;
#pragma unroll
        for (int mt = 0; mt < 16; ++mt)
#pragma unroll
            for (int r = 0; r < 4; ++r) { const float e = __expf((sacc[mt][r] - mx) * 0.0625f); sacc[mt][r] = e; sum += e; }
        sum += __shfl_xor(sum, 16); sum += __shfl_xor(sum, 32);
        const float inv = 1.f / sum;
#pragma unroll
        for (int mt = 0; mt < 16; ++mt) { u32x2 w; w.x = cvt_pk_bf16(sacc[mt][0] * inv, sacc[mt][1] * inv); w.y = cvt_pk_bf16(sacc[mt][2] * inv, sacc[mt][3] * inv);
            *(LAS u32x2*)(PSw + fr * 528 + (16 * mt + 4 * fq) * 2) = w; }
    }
    f32x4 oacc[16];
#pragma unroll
    for (int i = 0; i < 16; ++i) oacc[i] = (f32x4){0.f, 0.f, 0.f, 0.f};
#pragma unroll
    for (int half = 0; half < 2; ++half) {
        attn_stage<F32SRC>(lds, Vb, half);
        __syncthreads();
        if (active) {
#pragma unroll
            for (int k = 0; k < 4; ++k) { const bf16x8 pfrag = *(const LAS bf16x8*)(PSw + fr * 528 + (128 * half + 32 * k + fq * 8) * 2);
#pragma unroll
                for (int d0 = 0; d0 < 16; d0 += 8) { s16x4 lo[8], hi[8];
#pragma unroll
                    for (int e = 0; e < 8; ++e) { LAS unsigned char* va = lds + (32 * k + 8 * fq + (fr >> 2)) * 528 + (16 * (d0 + e) + 4 * (fr & 3)) * 2;
                        lo[e] = __builtin_amdgcn_ds_read_tr16_b64_v4i16((LAS s16x4*)va); hi[e] = __builtin_amdgcn_ds_read_tr16_b64_v4i16((LAS s16x4*)(va + 4 * 528)); }
#pragma unroll
                    for (int e = 0; e < 8; ++e) { bf16x8 vf; vf[0] = lo[e][0]; vf[1] = lo[e][1]; vf[2] = lo[e][2]; vf[3] = lo[e][3]; vf[4] = hi[e][0]; vf[5] = hi[e][1]; vf[6] = hi[e][2]; vf[7] = hi[e][3];
                        oacc[d0 + e] = MFMA16(vf, pfrag, oacc[d0 + e]); } } }
        }
        __syncthreads();
    }
    if (active && 16 * wid + fr < nrows) {
        bf16_t* op = O + (size_t)(16 * wid + fr) * 1024 + 4 * fq;
#pragma unroll
        for (int dt = 0; dt < 16; ++dt) { u32x2 w; w.x = cvt_pk_bf16(oacc[dt][0], oacc[dt][1]); w.y = cvt_pk_bf16(oacc[dt][2], oacc[dt][3]); *(u32x2*)(op + 16 * dt) = w; }
    }
}

__device__ __forceinline__ void conv_states(const P& p, int bid, int G) {
    const bf16_t* PROJ = (const bf16_t*)(p.ws + WS_PROJ);
    const int total = 12288 + 36864 + 393216 + 1179648;
    for (int i = bid * NTHR + threadIdx.x; i < total; i += G * NTHR) {
        int e = i; size_t oo; int bj, ch, col0, W; size_t rowbase; int T;
        if (e < 12288) { oo = O_RCP; W = 1024; col0 = C_RX; T = 2048; rowbase = 0; }
        else if ((e -= 12288) < 36864) { oo = O_GCP; W = 3072; col0 = C_GQ; T = 2048; rowbase = 0; }
        else if ((e -= 36864) < 393216) { oo = O_RCS; W = 1024; col0 = C_RX; T = 8; rowbase = 8192; }
        else { e -= 393216; oo = O_GCS; W = 3072; col0 = C_GQ; T = 8; rowbase = 8192; }
        bj = e / W; ch = e - bj * W; const int b = bj / 3, j = bj - b * 3;
        p.out[oo + e] = bf2f(PROJ[(rowbase + (size_t)b * T + (T - 3 + j)) * NPROJ + col0 + ch]);
    }
}


#ifndef DBG_CHECK
#define DBG_CHECK 1
#endif
__device__ __forceinline__ float blk_sum(LAS float* red, float v) {
    __syncthreads();
#pragma unroll
    for (int o = 32; o >= 1; o >>= 1) v += __shfl_xor(v, o);
    if ((threadIdx.x & 63) == 0) red[threadIdx.x >> 6] = v;
    __syncthreads();
    float t = 0.f;
#pragma unroll
    for (int i = 0; i < 8; ++i) t += red[i];
    return t;
}
__device__ __forceinline__ void dbg_flag(const P& p, unsigned id) { atomicMax((unsigned*)p.ws, id); }
__global__ void __launch_bounds__(NTHR) dbg_check_gemm1(P p) {
    __shared__ float red_s[8]; LAS float* red = (LAS float*)red_s; const int tid = threadIdx.x, bid = blockIdx.x;
    for (int s = bid; s < 1024; s += gridDim.x) {
        const int row = (s * 37 + 11) % 9216; const int oc = (int)(((long)s * 5303 + 7) % 13328);
        const int pc = oc < 6144 ? oc : (oc < 6160 ? 13312 + (oc - 6144) : oc - 16);
        const float* x = row < 8192 ? p.in[0] + (size_t)row * 2048 : p.in[1] + (size_t)(row - 8192) * 2048;
        float ss = 0.f, dot = 0.f;
        for (int k = tid; k < 2048; k += NTHR) { const float xv = x[k]; ss += xv * xv; dot += xv * p.in[9][k] * p.in[10][(size_t)k * 13328 + oc]; }
        ss = blk_sum(red, ss); dot = blk_sum(red, dot);
        float ref = dot * rsqrtf(ss * (1.f / 2048.f) + 1e-6f);
        const int pn = pc >> 8; const int act = (pn >= 4 && pn < 8) ? 1 : (pn >= 20 && pn < 24) ? 2 : (pn >= 28 && pn < 52) ? 3 : 0;
        float got;
        if (pc >= 13312) got = ((const float*)(p.ws + WS_GBA))[(size_t)row * 16 + (pc - 13312)];
        else { got = bf2f(((const bf16_t*)(p.ws + WS_PROJ))[(size_t)row * NPROJ + pc]); if (act) ref = actf(ref, act); }
        if (tid == 0 && !(fabsf(got - ref) <= 0.03f + 0.03f * fabsf(ref))) dbg_flag(p, 1u + (unsigned)(pn >= 52 ? 5 : pn >= 28 ? 4 : pn >= 24 ? 3 : pn >= 8 ? 2 : pn >= 4 ? 1 : 0));
    }
    for (int s = bid; s < 256; s += gridDim.x) {
        const int row = (s * 29 + 3) % 1024; const int oc = (s * 523 + 5) % 2048;
        const float* x = p.in[2] + (size_t)row * 2048;
        float ss = 0.f, dot = 0.f;
        for (int k = tid; k < 2048; k += NTHR) { const float xv = x[k]; ss += xv * xv; dot += xv * p.in[22][k] * p.in[23][(size_t)k * 2048 + oc]; }
        ss = blk_sum(red, ss); dot = blk_sum(red, dot);
        const float ref = dot * rsqrtf(ss * (1.f / 2048.f) + 1e-6f);
        const float got = oc < 1024 ? p.out[O_MK + (size_t)row * 1024 + oc] : p.out[O_MV + (size_t)row * 1024 + oc - 1024];
        if (tid == 0 && !(fabsf(got - ref) <= 0.03f + 0.03f * fabsf(ref))) dbg_flag(p, 10u);
    }
}

__global__ void dbg_scan_bf16(P p, size_t off, size_t n, float bound, unsigned id) {
    const bf16_t* q = (const bf16_t*)(p.ws + off); bool bad = false;
    for (size_t i = (size_t)blockIdx.x * blockDim.x + threadIdx.x; i < n; i += (size_t)gridDim.x * blockDim.x) { const float v = bf2f(q[i]); if (!(fabsf(v) <= bound)) bad = true; }
    if (bad) atomicMax((unsigned*)p.ws, id);
}
__global__ void dbg_scan_f32(P p, const float* q, size_t n, float lo, float hi, unsigned id) {
    bool bad = false;
    for (size_t i = (size_t)blockIdx.x * blockDim.x + threadIdx.x; i < n; i += (size_t)gridDim.x * blockDim.x) { const float v = q[i]; if (!(v >= lo && v <= hi)) bad = true; }
    if (bad) atomicMax((unsigned*)p.ws, id);
}
__global__ void dbg_scan_gp(P p, int suboff, int sublen, float bound, unsigned id) {
    bool bad = false;
    for (int item = blockIdx.x; item < 1024; item += gridDim.x) { const bf16_t* q = (const bf16_t*)(p.ws + WS_GP) + (size_t)item * 36864 + suboff;
        for (int i = threadIdx.x; i < sublen; i += blockDim.x) { const float v = bf2f(q[i]); if (!(fabsf(v) <= bound)) bad = true; } }
    if (bad) atomicMax((unsigned*)p.ws, id);
}
__global__ void dbg_scan2(P p, size_t base, size_t stride, int sublen, float bound, unsigned id_nan, unsigned id_big) {
    bool nan = false, big = false;
    for (int item = blockIdx.x; item < 1024; item += gridDim.x) { const bf16_t* q = (const bf16_t*)(p.ws + base) + (size_t)item * stride;
        for (int i = threadIdx.x; i < sublen; i += blockDim.x) { const float v = bf2f(q[i]); if (v != v) nan = true; else if (fabsf(v) > bound) big = true; } }
    if (nan) atomicMax((unsigned*)p.ws, id_nan); if (big) atomicMax((unsigned*)p.ws, id_big);
}
__global__ void dbg_scanbit(P p, size_t base, size_t stride, int sublen, float bound, unsigned bit) {
    bool bad = false;
    for (int item = blockIdx.x; item < 1024; item += gridDim.x) { const bf16_t* q = (const bf16_t*)(p.ws + base) + (size_t)item * stride;
        for (int i = threadIdx.x; i < sublen; i += blockDim.x) { const float v = bf2f(q[i]); if (!(fabsf(v) <= bound)) bad = true; } }
    if (bad) atomicOr((unsigned*)p.ws + 1, 1u << bit);
}
__global__ void dbg_report(P p) { const unsigned f = *(const unsigned*)p.ws, m = ((const unsigned*)p.ws)[1]; if (m) p.out[O_Y] = 1000.f * (float)(10u + m); else if (f) p.out[O_Y] = 1000.f * (float)f; }

__global__ void __launch_bounds__(NTHR, 2) mega(P p) {
    extern __shared__ __attribute__((aligned(16))) unsigned char lds_raw[];
    LAS unsigned char* lds = (LAS unsigned char*)lds_raw;
    cg::grid_group grid = cg::this_grid();
    const int G = gridDim.x, bid = blockIdx.x, tid = threadIdx.x;
    unsigned char* ws = p.ws;
#define PH(k) (p.ph_lo <= (k) && (k) < p.ph_hi)
#define SEAM(k) do { if (PH(k) && PH((k) + 1)) grid.sync(); } while (0)

    if (PH(0)) phase0(lds, p, bid, G);
    SEAM(0);

    if (PH(1)) {
        { pg8::Gemm g{(const bf16_t*)(ws + WS_XN), (const bf16_t*)(ws + WS_WIN), 9216, NPROJ, 2048, 0}; pg8::StaticOrder S; S.init(9216, NPROJ, G, bid);
          pg8::EpiProj E{(bf16_t*)(ws + WS_PROJ), (float*)(ws + WS_GBA)}; if (EN_GEMM) pg8::gemm_phase(lds, g, S, E); }
        { pg8::Gemm g{(const bf16_t*)(ws + WS_MEMN), (const bf16_t*)(ws + WS_WMKV), 1024, 2048, 2048, 0}; pg8::StaticOrder S; S.init(1024, 2048, G, G - 1 - bid);
          pg8::EpiMemKV E{p.out + O_MK, p.out + O_MV, (bf16_t*)(ws + WS_MKB), (bf16_t*)(ws + WS_MVB)}; if (EN_GEMM) pg8::gemm_phase(lds, g, S, E); }
    }
    SEAM(1);

    if (PH(2)) {
        for (int it = bid; it < 1024 + 512; it += G) {
            if (it < 1024) { if (EN_PREP) gdn_prep_item(lds, p, it); }
            else { const int k = it - 1024, b = k >> 2, h = k & 3;
                if (EN_ATTS) attn_item<true>(lds, (const bf16_t*)(ws + WS_PROJ) + (size_t)(8192 + b * 8) * NPROJ + C_MQ + h * 256, 8,
                                p.in[3] + (size_t)b * 262144 + h * 256, p.in[4] + (size_t)b * 262144 + h * 256,
                                (bf16_t*)(ws + WS_YCAT) + (size_t)2 * 9216 * 1024 + (size_t)(8192 + b * 8) * 1024 + h * 256); }
        }
        conv_states(p, bid, G);
    }
    SEAM(2);

    if (PH(3)) {
        const int NMISC = 256 + 512 + 256;
        if (bid < 32) { if (EN_SEQ && (p.roles & 1)) gdn_seq_item(lds, p, bid); } else if (bid < 160) { if (EN_RGP && (p.roles & 2)) rglru_item<true>(lds, p, bid - 32); }
        if (bid >= 160) {
            int tb = 0; const int b2 = bid - 160, g2 = G - 160;
            tconv(lds, p.in[24], 1024, 2048, (bf16_t*)(ws + WS_WUPS), 2048, nullptr, false, tb, b2, g2);
            tconv(lds, p.in[25], 1024, 2048, (bf16_t*)(ws + WS_WUPS) + (size_t)2048 * 1024, 2048, nullptr, false, tb, b2, g2);
            tconv(lds, p.in[26], 1024, 2048, (bf16_t*)(ws + WS_WUPS) + (size_t)2 * 2048 * 1024, 2048, nullptr, false, tb, b2, g2);
            tconv(lds, p.in[27], 2048, 2048, (bf16_t*)(ws + WS_WOUT), 2048, nullptr, false, tb, b2, g2);
            tconv(lds, p.in[29], 2048, 8192, (bf16_t*)(ws + WS_WUP), 8192, p.in[28], false, tb, b2, g2);
            tconv(lds, p.in[30], 8192, 2048, (bf16_t*)(ws + WS_WDN), 2048, nullptr, false, tb, b2, g2);
        }
        if (p.roles & 4) {
            LAS int* slot = (LAS int*)(lds + 137216);
            for (;;) {
                __syncthreads();
                if (tid == 0) *slot = (int)atomicAdd((unsigned*)ws + 16, 1u);
                __syncthreads();
                const int it = *slot;
                if (it >= NMISC) break;
                if (it < 256) { const int b = it >> 6, h = (it >> 4) & 3, t = it & 15; const size_t row0 = (size_t)b * 2048 + t * 128;
                    if (EN_ATTP) attn_item<false>(lds, (const bf16_t*)(ws + WS_PROJ) + row0 * NPROJ + C_MQ + h * 256, 128,
                                     (const bf16_t*)(ws + WS_MKB) + (size_t)b * 262144 + h * 256, (const bf16_t*)(ws + WS_MVB) + (size_t)b * 262144 + h * 256,
                                     (bf16_t*)(ws + WS_YCAT) + (size_t)2 * 9216 * 1024 + row0 * 1024 + h * 256); }
                else if (it < 768) { if (EN_GS) gdn_sample_pass(lds, p, it - 256); }
                else { if (EN_RGS) rglru_item<false>(lds, p, it - 768); }
            }
        }
    }
    SEAM(3);

    if (PH(4)) {
        pg8::Gemm g{(const bf16_t*)(ws + WS_YCAT), (const bf16_t*)(ws + WS_WUPS), 3 * 9216, 3 * 2048, 1024, 0}; pg8::TripleOrder S{G, bid};
        pg8::EpiMerge E{(const bf16_t*)(ws + WS_PROJ), (float*)(ws + WS_GP), (bf16_t*)(ws + WS_MERGED)}; if (EN_GEMM) pg8::gemm_phase(lds, g, S, E);
    }
    SEAM(4);

    if (PH(5)) {
        pg8::Gemm g{(const bf16_t*)(ws + WS_MERGED), (const bf16_t*)(ws + WS_WOUT), 9216, 2048, 2048, 0}; pg8::StaticOrder S; S.init(9216, 2048, G, bid);
        pg8::EpiOut E{p.in[0], p.in[1], p.out + O_Y, (bf16_t*)(ws + WS_XN), (float*)(ws + WS_SS1)}; if (EN_GEMM) pg8::gemm_phase(lds, g, S, E);
    }
    SEAM(5);

    if (PH(6)) {
        pg8::Gemm g{(const bf16_t*)(ws + WS_XN), (const bf16_t*)(ws + WS_WUP), 9216, 8192, 2048, 0}; pg8::StaticOrder S; S.init(9216, 8192, G, bid);
        pg8::EpiUp E{(const float*)(ws + WS_SS1), (bf16_t*)(ws + WS_PROJ)}; if (EN_GEMM) pg8::gemm_phase(lds, g, S, E);
    }
    SEAM(6);

    if (PH(7)) {
        { pg8::Gemm g{(const bf16_t*)(ws + WS_PROJ), (const bf16_t*)(ws + WS_WDN), 9216, 2048, 8192, 0}; pg8::DownMain S{G, bid};
          pg8::EpiDown E{p.out + O_Y, (const bf16_t*)(ws + WS_XN)}; if (EN_GEMM) pg8::gemm_phase(lds, g, S, E); }
        { pg8::Gemm g{(const bf16_t*)(ws + WS_PROJ), (const bf16_t*)(ws + WS_WDN), 9216, 2048, 8192, 16}; pg8::DownTail S{G, bid};
          pg8::EpiDownPart E{(bf16_t*)(ws + WS_GP)}; if (EN_GEMM) pg8::gemm_phase(lds, g, S, E); }
    }
    SEAM(7);

    if (PH(8)) {
        const int lane = tid & 63, wid = tid >> 6; const bf16_t* part = (const bf16_t*)(ws + WS_GP);
        for (int row = bid * 8 + wid; row < 9216; row += G * 8) { float* x = p.out + O_Y + (size_t)row * 2048; f32x4 v[8]; float ss = 0.f;
            if (row < 8192) {
#pragma unroll
                for (int i = 0; i < 8; ++i) { const int c = (i * 64 + lane) * 4; v[i] = *(const f32x4*)(x + c); }
            } else { const bf16_t* xb = (const bf16_t*)(ws + WS_XN) + (size_t)row * 2048;
#pragma unroll
                for (int i = 0; i < 8; ++i) { const u32x2 r = *(const u32x2*)(xb + (i * 64 + lane) * 4); v[i] = (f32x4){bf_lo(r.x), bf_hi(r.x), bf_lo(r.y), bf_hi(r.y)}; }
#pragma unroll 1
                for (int sl = 0; sl < 8; ++sl) { const bf16_t* pr = part + ((size_t)sl * 1024 + (row - 8192)) * 2048;
#pragma unroll
                    for (int i = 0; i < 8; ++i) { const u32x2 r = *(const u32x2*)(pr + (i * 64 + lane) * 4); v[i][0] += bf_lo(r.x); v[i][1] += bf_hi(r.x); v[i][2] += bf_lo(r.y); v[i][3] += bf_hi(r.y); } } }
#pragma unroll
            for (int i = 0; i < 8; ++i) ss += v[i][0] * v[i][0] + v[i][1] * v[i][1] + v[i][2] * v[i][2] + v[i][3] * v[i][3];
#pragma unroll
            for (int o = 32; o >= 1; o >>= 1) ss += __shfl_xor(ss, o);
            const float rs = rsqrtf(ss * (1.f / 2048.f) + 1e-6f);
#pragma unroll
            for (int i = 0; i < 8; ++i) { const int c = (i * 64 + lane) * 4; *(f32x4*)(x + c) = v[i] * rs * *(const f32x4*)(p.in[31] + c); } }
    }
#undef PH
#undef SEAM
}

extern "C" void kernel_launch(void* const* d_in, const int* in_sizes, int n_in, void* d_out, int out_size, void* d_ws, size_t ws_size, hipStream_t stream) {
    static int grid = 0;
    if (grid == 0) {
        if (n_in != 32 || out_size != 40030208 || ws_size < WS_END) { fprintf(stderr, "kernel_launch: unexpected shapes (n_in %d, out %d, ws %zu; need ws >= %zu)\n", n_in, out_size, ws_size, (size_t)WS_END); grid = -1; return; }
        int dev = 0, cus = 0, per_cu = 0;
        hipGetDevice(&dev); hipDeviceGetAttribute(&cus, hipDeviceAttributeMultiprocessorCount, dev);
        if (hipFuncSetAttribute((const void*)mega, hipFuncAttributeMaxDynamicSharedMemorySize, LDS_BYTES) != hipSuccess) { fprintf(stderr, "kernel_launch: hipFuncSetAttribute failed\n"); grid = -1; return; }
        if (hipOccupancyMaxActiveBlocksPerMultiprocessor(&per_cu, (const void*)mega, NTHR, LDS_BYTES) != hipSuccess || per_cu < 1) { fprintf(stderr, "kernel_launch: occupancy query says %d\n", per_cu); (void)hipGetLastError(); per_cu = 1; }
        grid = cus * 1;
        if (grid < 192) { fprintf(stderr, "kernel_launch: needs >= 192 CUs (got %d)\n", grid); grid = -1; return; }
    }
    if (grid < 0) return;
    P p{};
    for (int i = 0; i < 32; ++i) p.in[i] = (const float*)d_in[i];
    p.out = (float*)d_out; p.ws = (unsigned char*)d_ws; p.roles = 7;
#if defined(PROBE_SEGS)
    { static const int segs[][2] = PROBE_SEGS; const int nseg = (int)(sizeof(segs) / sizeof(segs[0]));
      for (int si = 0; si < nseg; ++si) { P q = p; q.ph_lo = segs[si][0]; q.ph_hi = segs[si][1]; if (si == 1) q.roles = PROBE_ROLES; void* qa[] = {&q};
          if (q.ph_hi - q.ph_lo > 1) (void)hipLaunchCooperativeKernel((const void*)mega, dim3(grid), dim3(NTHR), qa, LDS_BYTES, stream);
          else hipLaunchKernelGGL(mega, dim3(grid), dim3(NTHR), LDS_BYTES, stream, q); } }
#elif ONE_LAUNCH
    p.ph_lo = 0; p.ph_hi = DBG_PH_HI;
    void* args[] = {&p};
    hipError_t e = hipLaunchCooperativeKernel((const void*)mega, dim3(grid), dim3(NTHR), args, LDS_BYTES, stream);
    if (e != hipSuccess) fprintf(stderr, "cooperative launch failed: %s (grid %d)\n", hipGetErrorString(e), grid);
#else
    (void)hipMemsetAsync(d_ws, 0, 256, stream);
    for (int k = 0; k < DBG_PH_HI; ++k) { p.ph_lo = k; p.ph_hi = k + 1; hipLaunchKernelGGL(mega, dim3(grid), dim3(NTHR), LDS_BYTES, stream, p);
        if (k == 1) hipLaunchKernelGGL(dbg_check_gemm1, dim3(256), dim3(NTHR), 0, stream, p);
        if (k == 2) { hipLaunchKernelGGL(dbg_scan_f32, dim3(4), dim3(256), 0, stream, p, (const float*)((unsigned char*)d_ws + WS_DEC), (size_t)1024, 0.f, 1.f, 21u);
            hipLaunchKernelGGL(dbg_scanbit, dim3(256), dim3(256), 0, stream, p, (size_t)WS_GP, (size_t)36864, 8192, 100.f, 0u);
            hipLaunchKernelGGL(dbg_scanbit, dim3(256), dim3(256), 0, stream, p, (size_t)WS_GP + 16384 * 2, (size_t)36864, 8192, 100.f, 1u); }
    }
    hipLaunchKernelGGL(dbg_report, dim3(1), dim3(1), 0, stream, p);
#endif
}
```
